# Optimizing an MI355X kernel written in HIP

```python
import math
import jax
import jax.numpy as jnp
from jax import lax
import numpy as np

D_MODEL = 1024
BATCH = 8
SEQ = 4096
DEPTH = 1

GRID_W = 64
CTX_LEN = 256
DN_HEADS = 4
DN_HEAD_DIM = 128
DN_WIDTH = DN_HEADS * DN_HEAD_DIM
SHORT_CONV = 5
CHUNK = 64
POOL_GROUPS = 4
POOL_WINDOWS = (2, 4, 8, 16)
POOL_WIDTH = D_MODEL - DN_WIDTH
POOL_GROUP_DIM = POOL_WIDTH // POOL_GROUPS
MIX_WIDTH = DN_WIDTH + POOL_WIDTH
D_FF = 128 * ((8 * D_MODEL // 3 + 127) // 128)
FFN_CONV = 3
N_MOD = 6
NORM_EPS = 1e-6
Q_OFF = 0
K_OFF = DN_WIDTH
V_OFF = 2 * DN_WIDTH
Z_OFF = 3 * DN_WIDTH
GATE_OFF = 4 * DN_WIDTH
POOL_OFF = GATE_OFF + 4 * DN_HEADS
IN_COLS = POOL_OFF + POOL_WIDTH

kernel_name = 'hymba_gdn_pool_convffn_dit_block'


def rms_norm(x, g):
    xf = x.astype(jnp.float32)
    y = xf * lax.rsqrt(jnp.mean(xf * xf, axis=-1, keepdims=True) + NORM_EPS)
    return (y * g.astype(jnp.float32)).astype(x.dtype)


def l2_normalize(x):
    xf = x.astype(jnp.float32)
    return xf * lax.rsqrt(jnp.sum(xf * xf, axis=-1, keepdims=True) + NORM_EPS)


def modulation(cond, w_mod, b_mod):
    m = jax.nn.silu(cond) @ w_mod + b_mod
    return jnp.split(m[..., None, :], N_MOD, axis=-1)


def depthwise_conv(x, w):
    pad = w.shape[0] // 2
    return lax.conv_general_dilated(x, w[:, None, :], window_strides=(1,), padding=[(pad, pad)],
                                    dimension_numbers=('NWC', 'WIO', 'NWC'),
                                    feature_group_count=x.shape[-1])


def split_heads(a):
    return a.reshape(*a.shape[:-1], -1, DN_HEAD_DIM)


def gated_delta_rule(q, k, v, g, beta, s0):
    bsz, t, nh, dk = k.shape
    n = t // CHUNK

    def to_chunks(a):
        a = a.astype(jnp.float32).reshape(bsz, n, CHUNK, nh, *a.shape[3:])
        return jnp.moveaxis(a, 3, 1)

    k_c, v_c = to_chunks(k), to_chunks(v)
    gcum = jnp.cumsum(to_chunks(g), axis=-1)
    b_c = to_chunks(beta)[..., None]
    incl = jnp.tril(jnp.ones((CHUNK, CHUNK), dtype=bool))
    strict = jnp.tril(jnp.ones((CHUNK, CHUNK), dtype=bool), k=-1)
    decay = jnp.exp(jnp.where(incl, gcum[..., :, None] - gcum[..., None, :], -jnp.inf))
    kb = k_c * b_c
    lower = jnp.where(strict, jnp.einsum('bhnid,bhnjd->bhnij', kb, k_c) * decay, 0.0)
    eye = jnp.eye(CHUNK, dtype=jnp.float32)
    t_inv = lax.linalg.triangular_solve(lower + eye, jnp.broadcast_to(eye, lower.shape),
                                        left_side=True, lower=True, unit_diagonal=True)
    u_c = jnp.einsum('bhnij,bhnjv->bhniv', t_inv, v_c * b_c)
    w_c = jnp.einsum('bhnij,bhnjk->bhnik', t_inv, kb * jnp.exp(gcum)[..., None])
    g_last = gcum[..., -1]
    k_dec = k_c * jnp.exp(g_last[..., None] - gcum)[..., None]

    def seq_first(a):
        return jnp.moveaxis(a, 2, 0)

    xs = [seq_first(a) for a in (u_c, w_c, k_dec, g_last)]
    with_out = q is not None
    if with_out:
        q_c = to_chunks(q) * dk ** -0.5
        attn = jnp.where(incl, jnp.einsum('bhnik,bhnjk->bhnij', q_c, k_c) * decay, 0.0)
        xs += [seq_first(q_c * jnp.exp(gcum)[..., None]), seq_first(attn)]

    def step(s, xs_n):
        u_n, w_n, kd_n, gl_n = xs_n[:4]
        v_new = u_n - jnp.einsum('bhck,bhkv->bhcv', w_n, s)
        s_new = s * jnp.exp(gl_n)[..., None, None] + jnp.einsum('bhck,bhcv->bhkv', kd_n, v_new)
        if not with_out:
            return s_new, None
        qd_n, a_n = xs_n[4:]
        o_n = (jnp.einsum('bhck,bhkv->bhcv', qd_n, s)
               + jnp.einsum('bhij,bhjv->bhiv', a_n, v_new))
        return s_new, o_n

    s_fin, o = lax.scan(step, s0, tuple(xs))
    if not with_out:
        return None, s_fin
    o = jnp.moveaxis(jnp.moveaxis(o, 0, 2), 1, 3).reshape(bsz, t, nh, -1)
    return o, s_fin


def dn_gates(p_gate, a_log, dt_bias):
    pf = p_gate.astype(jnp.float32)
    b_f, b_b, a_f, a_b = jnp.split(pf, 4, axis=-1)

    def log_decay(a, d):
        return -jnp.exp(a_log[d].astype(jnp.float32)) * jax.nn.softplus(a + dt_bias[d].astype(jnp.float32))

    return (log_decay(a_f, 0), jax.nn.sigmoid(b_f)), (log_decay(a_b, 1), jax.nn.sigmoid(b_b))


def bidirectional_delta(q, k, v, gates, s0_f, s0_b):
    (g_f, beta_f), (g_b, beta_b) = gates

    def flip(a):
        return None if a is None else jnp.flip(a, axis=1)

    o_f, s_f = gated_delta_rule(q, k, v, g_f, beta_f, s0_f)
    o_b, s_b = gated_delta_rule(flip(q), flip(k), flip(v), flip(g_b), flip(beta_b), s0_b)
    o = None if q is None else o_f + flip(o_b)
    return o, s_f, s_b


def box_mean(u, w, axis):
    n = u.shape[axis]
    left = w // 2
    right = w - 1 - left
    cs = jnp.cumsum(u, axis=axis)
    cs = jnp.concatenate([jnp.zeros_like(lax.slice_in_dim(cs, 0, 1, axis=axis)), cs], axis=axis)
    idx = jnp.arange(n)
    lo = jnp.clip(idx - left, 0, n)
    hi = jnp.clip(idx + right + 1, 0, n)
    total = jnp.take(cs, hi, axis=axis) - jnp.take(cs, lo, axis=axis)
    shape = [1] * u.ndim
    shape[axis] = n
    return total / (hi - lo).astype(u.dtype).reshape(shape)


def pool_mixer(u, pool_w, pool_scale, rows):
    bsz, t, _ = u.shape
    if rows is None:
        spatial, axes = (t,), (1,)
    else:
        spatial, axes = (rows, GRID_W), (1, 2)
    uf = u.astype(jnp.float32).reshape(bsz, *spatial, POOL_GROUPS, POOL_GROUP_DIM)
    diffs = []
    for gi, w in enumerate(POOL_WINDOWS):
        ug = uf[..., gi, :]
        m = ug
        for ax in axes:
            m = box_mean(m, w, ax)
        diffs.append(m - ug)
    d = jnp.stack(diffs, axis=-2).reshape(bsz, t, POOL_GROUPS, POOL_GROUP_DIM).astype(u.dtype)
    y = jnp.einsum('btgc,gcd->btgd', d, pool_w).reshape(bsz, t, POOL_WIDTH)
    return y * pool_scale


def token_mixers(h, rows, s0_f, s0_b, w_in, conv_qkv, a_log, dt_bias, o_norm, pool_w, pool_scale, w_out):
    p = h @ w_in
    qkv = jax.nn.silu(depthwise_conv(p[..., Q_OFF:Z_OFF], conv_qkv))
    q, k, v = (split_heads(a) for a in jnp.split(qkv, 3, axis=-1))
    gates = dn_gates(p[..., GATE_OFF:POOL_OFF], a_log, dt_bias)
    o, s_f, s_b = bidirectional_delta(l2_normalize(q), l2_normalize(k), v, gates, s0_f, s0_b)
    z = split_heads(p[..., Z_OFF:GATE_OFF]).astype(jnp.float32)
    o = rms_norm(o, o_norm) * jax.nn.silu(z)
    dn_out = o.reshape(*h.shape[:-1], DN_WIDTH).astype(h.dtype)
    pool_out = pool_mixer(p[..., POOL_OFF:], pool_w, pool_scale, rows)
    y = jnp.concatenate([dn_out, pool_out], axis=-1) @ w_out
    return y, s_f, s_b


def context_states(hc, w_in, conv_qkv, a_log, dt_bias):
    kv = jax.nn.silu(depthwise_conv(hc @ w_in[:, K_OFF:Z_OFF], conv_qkv[:, K_OFF:Z_OFF]))
    k, v = (split_heads(a) for a in jnp.split(kv, 2, axis=-1))
    gates = dn_gates(hc @ w_in[:, GATE_OFF:POOL_OFF], a_log, dt_bias)
    zeros = jnp.zeros((hc.shape[0], DN_HEADS, DN_HEAD_DIM, DN_HEAD_DIM), jnp.float32)
    _, s_f, s_b = bidirectional_delta(None, l2_normalize(k), v, gates, zeros, zeros)
    return s_f, s_b


def conv_glu_ffn(h, w_up, conv_w, w_down):
    gate, up = jnp.split(h @ w_up, 2, axis=-1)
    return (jax.nn.silu(depthwise_conv(gate, conv_w)) * up) @ w_down


def layer(x, ctx, c, c_ctx, rows, update_ctx, w_mod, b_mod, g_pre_mix, g_post_mix, g_pre_ffn,
          g_post_ffn, w_in, conv_qkv, a_log, dt_bias, o_norm, pool_w, pool_scale, w_out,
          w_up, conv_ffn, w_down):
    sh1, sc1, gt1, sh2, sc2, gt2 = modulation(c, w_mod, b_mod)
    csh1, csc1, cgt1, csh2, csc2, cgt2 = modulation(c_ctx, w_mod, b_mod)
    mix_params = (w_in, conv_qkv, a_log, dt_bias, o_norm, pool_w, pool_scale, w_out)
    hx = rms_norm(x, g_pre_mix) * (1 + sc1) + sh1
    hc = rms_norm(ctx, g_pre_mix) * (1 + csc1) + csh1
    if update_ctx:
        zeros = jnp.zeros((ctx.shape[0], DN_HEADS, DN_HEAD_DIM, DN_HEAD_DIM), jnp.float32)
        yc, s_f, s_b = token_mixers(hc, None, zeros, zeros, *mix_params)
    else:
        s_f, s_b = context_states(hc, w_in, conv_qkv, a_log, dt_bias)
    yx, _, _ = token_mixers(hx, rows, s_f, s_b, *mix_params)
    x = x + gt1 * rms_norm(yx, g_post_mix)
    hx = rms_norm(x, g_pre_ffn) * (1 + sc2) + sh2
    x = x + gt2 * rms_norm(conv_glu_ffn(hx, w_up, conv_ffn, w_down), g_post_ffn)
    if update_ctx:
        ctx = ctx + cgt1 * rms_norm(yc, g_post_mix)
        hc = rms_norm(ctx, g_pre_ffn) * (1 + csc2) + csh2
        ctx = ctx + cgt2 * rms_norm(conv_glu_ffn(hc, w_up, conv_ffn, w_down), g_post_ffn)
    return x, ctx


def setup_inputs(seed: int = 0) -> dict:
    key = jax.random.key(seed)
    ks = jax.random.split(key, 21)
    f32 = jnp.float32

    def nrm(k, shape, scale):
        return jax.random.normal(k, shape, f32) * scale

    dt = jnp.exp(jax.random.uniform(ks[13], (DEPTH, 2, DN_HEADS), f32,
                                    minval=math.log(1e-3), maxval=math.log(1e-1)))
    return {
        'x': nrm(ks[0], (BATCH, SEQ, D_MODEL), 1.0),
        'c': nrm(ks[1], (BATCH, D_MODEL), 1.0),
        'ctx': nrm(ks[2], (BATCH, CTX_LEN, D_MODEL), 1.0),
        'c_ctx': nrm(ks[3], (D_MODEL,), 1.0),
        'w_mod': nrm(ks[4], (DEPTH, D_MODEL, N_MOD * D_MODEL), 0.5 * D_MODEL ** -0.5),
        'b_mod': nrm(ks[5], (DEPTH, N_MOD * D_MODEL), 0.02),
        'g_pre_mix': 1.0 + nrm(ks[6], (DEPTH, D_MODEL), 0.05),
        'g_post_mix': 1.0 + nrm(ks[7], (DEPTH, D_MODEL), 0.05),
        'g_pre_ffn': 1.0 + nrm(ks[8], (DEPTH, D_MODEL), 0.05),
        'g_post_ffn': 1.0 + nrm(ks[9], (DEPTH, D_MODEL), 0.05),
        'w_in': nrm(ks[10], (DEPTH, D_MODEL, IN_COLS), D_MODEL ** -0.5),
        'conv_qkv': nrm(ks[11], (DEPTH, SHORT_CONV, 3 * DN_WIDTH), SHORT_CONV ** -0.5),
        'a_log': jnp.log(jax.random.uniform(ks[12], (DEPTH, 2, DN_HEADS), f32, minval=1.0, maxval=16.0)),
        'dt_bias': jnp.log(jnp.expm1(dt)),
        'o_norm': 1.0 + nrm(ks[14], (DEPTH, DN_HEAD_DIM), 0.05),
        'pool_w': nrm(ks[15], (DEPTH, POOL_GROUPS, POOL_GROUP_DIM, POOL_GROUP_DIM), POOL_GROUP_DIM ** -0.5),
        'pool_scale': 1.0 + nrm(ks[16], (DEPTH, POOL_WIDTH), 0.05),
        'w_out': nrm(ks[17], (DEPTH, MIX_WIDTH, D_MODEL), MIX_WIDTH ** -0.5),
        'w_up': nrm(ks[18], (DEPTH, D_MODEL, 2 * D_FF), D_MODEL ** -0.5),
        'conv_ffn': nrm(ks[19], (DEPTH, FFN_CONV, D_FF), FFN_CONV ** -0.5),
        'w_down': nrm(ks[20], (DEPTH, D_FF, D_MODEL), D_FF ** -0.5),
    }


def reference(x, c, ctx, c_ctx, w_mod, b_mod, g_pre_mix, g_post_mix, g_pre_ffn, g_post_ffn,
              w_in, conv_qkv, a_log, dt_bias, o_norm, pool_w, pool_scale, w_out, w_up,
              conv_ffn, w_down):
    rows = x.shape[1] // GRID_W
    for i in range(DEPTH):
        x, ctx = layer(x, ctx, c, c_ctx, rows, i < DEPTH - 1,
                       w_mod[i], b_mod[i], g_pre_mix[i], g_post_mix[i], g_pre_ffn[i],
                       g_post_ffn[i], w_in[i], conv_qkv[i], a_log[i], dt_bias[i], o_norm[i],
                       pool_w[i], pool_scale[i], w_out[i], w_up[i], conv_ffn[i], w_down[i])
    return x
```

```cpp
#include <hip/hip_runtime.h>
#include <hip/hip_cooperative_groups.h>
#include <cstdio>
#include <cstdint>
namespace cg = cooperative_groups;
namespace pg8 {
#define PG8_LAS __attribute__((address_space(3)))
typedef unsigned short bf16_t;
typedef short bf16x8 __attribute__((ext_vector_type(8)));
typedef float f32x4 __attribute__((ext_vector_type(4)));
typedef unsigned u32x4 __attribute__((ext_vector_type(4)));
constexpr int BM = 256, BK = 64, HALF = 128, HTB = HALF * BK * 2  , STAGE_BYTES = 8 * HTB, NXCD = 8, WGM = 8;

__host__ __device__ __forceinline__ int lds_byte(int r, int c) { const int st = (r >> 4) * 2 + (c >> 5), rr = r & 15, cc = c & 31, ob = rr * 64 + cc * 2; return st * 1024 + (ob ^ (((ob >> 9) & 1) << 5)); }
__host__ __device__ __forceinline__ void stage_rc(int b, int& R, int& C) { const int st = b / 1024, sb = b % 1024, swz = sb ^ (((sb >> 9) & 1) << 5); R = (st >> 1) * 16 + swz / 64; C = (st & 1) * 32 + (swz % 64) / 2; }
__host__ __device__ __forceinline__ int perm32(int rho) { const int n = rho >> 4, i = rho & 15; return 8 * (i >> 2) + 4 * n + (i & 3); }

struct Unit { int pm, pn; };
struct Gemm { const bf16_t* A; const bf16_t* Bt; int M, N, K; };

struct StaticOrder {
    int nM, nN, nwg, G, c;
    __host__ __device__ void init(int M, int N, int G_, int c_) { nM = M / BM; nN = N / BM; nwg = nM * nN; G = G_; c = c_; }
    __host__ __device__ bool next(int i, Unit& u) const {
        const long L = (long)i * G + c; if (L >= nwg) return false;
        int wgid = (int)L; { const int q = nwg / NXCD, r = nwg % NXCD, xcd = wgid % NXCD, off = wgid / NXCD; wgid = (xcd < r ? xcd * (q + 1) : r * (q + 1) + (xcd - r) * q) + off; }
        const int nig = WGM * nN, gid = wgid / nig, fm = gid * WGM, gsz = (nM - fm) < WGM ? (nM - fm) : WGM;
        u.pm = fm + ((wgid % nig) % gsz); u.pn = (wgid % nig) / gsz; return true;
    }
    __device__ __forceinline__ void a_ready(const Unit&) const {}
    __device__ __forceinline__ void done(const Unit&) const {}
};

typedef __bf16 pg8_bf16x2 __attribute__((ext_vector_type(2)));
__device__ __forceinline__ unsigned cvt_pk_bf16(float lo, float hi) { typedef float f2_ __attribute__((ext_vector_type(2))); const f2_ v = {lo, hi}; return __builtin_bit_cast(unsigned, __builtin_convertvector(v, pg8_bf16x2)); }
typedef float f32x2 __attribute__((ext_vector_type(2)));
__device__ __forceinline__ f32x2 gelu_pk(f32x2 v) {
    const f32x2 av = __builtin_elementwise_abs(v), d = av * 0.2316418882f + 1.0f;
    f32x2 t; t.x = __builtin_amdgcn_rcpf(d.x); t.y = __builtin_amdgcn_rcpf(d.y);
    f32x2 q = t * 0.5307027145f + (-0.7265760135f); q = q * t + 0.7107068705f; q = q * t + (-0.142248368f); q = q * t + 0.127414796f; q = q * t;
    const f32x2 s = (v * v) * (-0.72134752044f);
    f32x2 e; e.x = __builtin_amdgcn_exp2f(s.x); e.y = __builtin_amdgcn_exp2f(s.y);
    const f32x2 m = v * (q * e), r = v - m;
    f32x2 o; o.x = v.x < 0.f ? m.x : r.x; o.y = v.y < 0.f ? m.y : r.y; return o;
}

template <int ACT  > struct EpiBf16 {
    static constexpr bool PERM = true, AFTER_DRAIN = false; static_assert(ACT == 0 || ACT == 1, "EpiBf16: ACT is 0 (none) or 1 (gelu_pk)");
    bf16_t* O; int ldc; const float* bias; int split_cols; size_t split_stride; float scale0;
    __device__ __forceinline__ void operator()(const f32x4 (&acc)[2][2][4][2], const Unit& u, int wr, int wc, int fr, int fq) const {
        const int row0 = u.pm * BM + wr * 64 + fr; int colt = u.pn * BM; bf16_t* base = O;
        float sc = 1.f; if (split_cols) { const int t = colt / split_cols; base += (size_t)t * split_stride; colt -= t * split_cols; if (t == 0) sc = scale0; }
        const int col0 = colt + wc * 32 + 8 * fq, bcol0 = u.pn * BM + wc * 32 + 8 * fq;
        f32x4 bv[2][2];
#pragma unroll
        for (int bj = 0; bj < 2; ++bj)
#pragma unroll
            for (int n = 0; n < 2; ++n) bv[bj][n] = bias ? *(const f32x4*)(bias + bcol0 + bj * HALF + 4 * n) : (f32x4){0.f, 0.f, 0.f, 0.f};
#pragma unroll
        for (int ai = 0; ai < 2; ++ai)
#pragma unroll
            for (int m = 0; m < 4; ++m) { bf16_t* rowp = base + (size_t)(row0 + ai * HALF + m * 16) * ldc + col0;
#pragma unroll
                for (int bj = 0; bj < 2; ++bj) { f32x4 v0 = acc[ai][bj][m][0] + bv[bj][0], v1 = acc[ai][bj][m][1] + bv[bj][1];
                    if (ACT == 1) { f32x2 a = gelu_pk((f32x2){v0[0], v0[1]}), b = gelu_pk((f32x2){v0[2], v0[3]}), c = gelu_pk((f32x2){v1[0], v1[1]}), d = gelu_pk((f32x2){v1[2], v1[3]});
                        v0 = (f32x4){a.x, a.y, b.x, b.y}; v1 = (f32x4){c.x, c.y, d.x, d.y}; }
                    v0 = v0 * sc; v1 = v1 * sc; u32x4 w; w.x = cvt_pk_bf16(v0[0], v0[1]); w.y = cvt_pk_bf16(v0[2], v0[3]); w.z = cvt_pk_bf16(v1[0], v1[1]); w.w = cvt_pk_bf16(v1[2], v1[3]);
                    *(u32x4*)(rowp + bj * HALF) = w; } }
    }
};
struct EpiAct {
    static constexpr bool PERM = true, AFTER_DRAIN = false;
    const bf16_t* G; bf16_t* O; int ldc; const float* cw;
    __device__ __forceinline__ void operator()(const f32x4 (&acc)[2][2][4][2], const Unit& u, int wr, int wc, int fr, int fq) const {
        const int row0 = u.pm * BM + wr * 64 + fr, col0 = u.pn * BM + wc * 32 + 8 * fq;
#pragma unroll
        for (int bj = 0; bj < 2; ++bj) {
            const int c = col0 + bj * HALF;
            float w[3][8];
#pragma unroll
            for (int j = 0; j < 3; ++j) { const f32x4 w0 = *(const f32x4*)(cw + (size_t)j * ldc + c), w1 = *(const f32x4*)(cw + (size_t)j * ldc + c + 4);
                w[j][0] = w0[0]; w[j][1] = w0[1]; w[j][2] = w0[2]; w[j][3] = w0[3]; w[j][4] = w1[0]; w[j][5] = w1[1]; w[j][6] = w1[2]; w[j][7] = w1[3]; }
#pragma unroll
            for (int ai = 0; ai < 2; ++ai)
#pragma unroll
                for (int m = 0; m < 4; ++m) {
                    const int r = row0 + ai * HALF + m * 16;
                    const bf16_t* gp = G + (size_t)r * ldc + c;
                    u32x4 pv = (u32x4){0u, 0u, 0u, 0u}, nv = pv;
                    if ((r & 4095) != 0) pv = *(const u32x4*)(gp - ldc);
                    if (((r + 1) & 4095) != 0) nv = *(const u32x4*)(gp + ldc);
                    const u32x4 cv = *(const u32x4*)gp;
                    const f32x4 v0 = acc[ai][bj][m][0], v1 = acc[ai][bj][m][1];
                    const float up[8] = {v0[0], v0[1], v0[2], v0[3], v1[0], v1[1], v1[2], v1[3]};
                    float o[8];
#pragma unroll
                    for (int q = 0; q < 4; ++q) {
                        const float p0 = __builtin_bit_cast(float, pv[q] << 16), p1 = __builtin_bit_cast(float, pv[q] & 0xffff0000u);
                        const float c0 = __builtin_bit_cast(float, cv[q] << 16), c1 = __builtin_bit_cast(float, cv[q] & 0xffff0000u);
                        const float n0 = __builtin_bit_cast(float, nv[q] << 16), n1 = __builtin_bit_cast(float, nv[q] & 0xffff0000u);
                        const float s0 = w[0][2 * q] * p0 + w[1][2 * q] * c0 + w[2][2 * q] * n0, s1 = w[0][2 * q + 1] * p1 + w[1][2 * q + 1] * c1 + w[2][2 * q + 1] * n1;
                        o[2 * q] = s0 * __builtin_amdgcn_rcpf(1.f + __expf(-s0)) * up[2 * q]; o[2 * q + 1] = s1 * __builtin_amdgcn_rcpf(1.f + __expf(-s1)) * up[2 * q + 1]; }
                    u32x4 wv; wv.x = cvt_pk_bf16(o[0], o[1]); wv.y = cvt_pk_bf16(o[2], o[3]); wv.z = cvt_pk_bf16(o[4], o[5]); wv.w = cvt_pk_bf16(o[6], o[7]);
                    *(u32x4*)(O + (size_t)r * ldc + c) = wv;
                }
        }
    }
};

template <class Epi, class Sched, bool ALIGN_EPI = false, bool SP2 = false>
__device__ __forceinline__ void gemm_phase(PG8_LAS unsigned char* lds, const Gemm g, const Sched& S, const Epi& E) {
    const int tid = threadIdx.x, wid = __builtin_amdgcn_readfirstlane(tid >> 6), lane = tid & 63, wr = wid >> 2, wc = wid & 3, fr = lane & 15, fq = lane >> 4;
    const int K = g.K, nt = K / BK;
    unsigned voffA[2], voffB[2];
#pragma unroll
    for (int i = 0; i < 2; ++i) { int R, C; stage_rc(tid * 16 + i * 8192, R, C); const int Rb = Epi::PERM ? ((R & ~31) + perm32(R & 31)) : R;
        voffA[i] = (unsigned)(R * K + C) * 2u; voffB[i] = (unsigned)(Rb * K + C) * 2u; }
    const size_t kstep = (size_t)(BK * 2);
    const size_t hstep = (size_t)HALF * K * 2;
    const size_t tstep = 2 * hstep;
    const unsigned ldsw = (unsigned)wid * 1024u;
    const int aoff = lds_byte(wr * 64 + fr, fq * 8), boff = lds_byte(wc * 32 + fr, fq * 8);
#define PG8_SA(b, h) (((b) * 2 + (h)) * HTB)
#define PG8_SB(b, h) ((4 + (b) * 2 + (h)) * HTB)
#define PG8_STAGE(bufoff, gbase, voff) do { _Pragma("unroll") for (int _i = 0; _i < 2; ++_i) \
        __builtin_amdgcn_global_load_lds((const unsigned*)((const char*)(gbase) + (voff)[_i]), (PG8_LAS unsigned*)(lds + (bufoff) + ldsw + _i * 8192), 16, 0, 0); } while (0)
#define PG8_LDA(dst, b, h) do { _Pragma("unroll") for (int m = 0; m < 4; ++m) _Pragma("unroll") for (int k = 0; k < 2; ++k) dst[m][k] = *(const PG8_LAS bf16x8*)(lds + PG8_SA(b, h) + aoff + m * 2048 + k * 1024); } while (0)
#define PG8_LDB(dst, b, h) do { _Pragma("unroll") for (int n = 0; n < 2; ++n) _Pragma("unroll") for (int k = 0; k < 2; ++k) dst[n][k] = *(const PG8_LAS bf16x8*)(lds + PG8_SB(b, h) + boff + n * 2048 + k * 1024); } while (0)
#define PG8_MMA(ai, bj, At, Bt) do { __builtin_amdgcn_s_setprio(1); _Pragma("unroll") for (int m = 0; m < 4; ++m) _Pragma("unroll") for (int n = 0; n < 2; ++n) _Pragma("unroll") for (int k = 0; k < 2; ++k) \
        acc[ai][bj][m][n] = __builtin_amdgcn_mfma_f32_16x16x32_bf16(Bt[n][k], At[m][k], acc[ai][bj][m][n], 0, 0, 0); __builtin_amdgcn_s_setprio(0); } while (0)
#define PG8_WAIT_V(n) asm volatile("s_waitcnt vmcnt(" #n ")" ::: "memory")
#define PG8_WAIT_L(n) asm volatile("s_waitcnt lgkmcnt(" #n ")" ::: "memory")
#define PG8_BAR __builtin_amdgcn_s_barrier()
#define PG8_SCHED __builtin_amdgcn_sched_barrier(0)
    Unit cur, nxt; int ui = 0;
    if (!S.next(0, cur)) return;
    f32x4 acc[2][2][4][2];
#pragma unroll
    for (int a = 0; a < 2; ++a)
#pragma unroll
        for (int b = 0; b < 2; ++b)
#pragma unroll
            for (int m = 0; m < 4; ++m)
#pragma unroll
                for (int n = 0; n < 2; ++n) acc[a][b][m][n] = (f32x4){0.f, 0.f, 0.f, 0.f};
    bf16x8 At[4][2], B0[2][2], B1[2][2];
    const char* cA = (const char*)g.A + (size_t)cur.pm * tstep; const char* cB = (const char*)g.Bt + (size_t)cur.pn * tstep;
    S.a_ready(cur);
    if constexpr (SP2) {
        PG8_STAGE(PG8_SB(0, 0), cB, voffB); PG8_STAGE(PG8_SB(0, 1), cB + hstep, voffB); PG8_STAGE(PG8_SA(0, 0), cA, voffA); PG8_STAGE(PG8_SA(0, 1), cA + hstep, voffA);
        if (wr == 1) PG8_BAR;
        PG8_WAIT_V(2); PG8_BAR;
        PG8_STAGE(PG8_SB(1, 0), cB + kstep, voffB); PG8_STAGE(PG8_SA(1, 0), cA + kstep, voffA); PG8_STAGE(PG8_SB(1, 1), cB + hstep + kstep, voffB);
        PG8_WAIT_V(6); PG8_BAR;
    } else {
        PG8_STAGE(PG8_SB(0, 0), cB, voffB); PG8_STAGE(PG8_SA(0, 0), cA, voffA); PG8_STAGE(PG8_SB(0, 1), cB + hstep, voffB); PG8_STAGE(PG8_SA(0, 1), cA + hstep, voffA);
        if (wr == 1) PG8_BAR;
        PG8_WAIT_V(4); PG8_BAR;
        PG8_STAGE(PG8_SB(1, 0), cB + kstep, voffB); PG8_STAGE(PG8_SA(1, 0), cA + kstep, voffA); PG8_STAGE(PG8_SB(1, 1), cB + hstep + kstep, voffB);
        PG8_WAIT_V(6); PG8_BAR;
    }
    for (;;) {
        const bool has_next = S.next(ui + 1, nxt);
        const char* nA = has_next ? (const char*)g.A + (size_t)nxt.pm * tstep : cA; const char* nB = has_next ? (const char*)g.Bt + (size_t)nxt.pn * tstep : cB;
        for (int t = 0; t < nt; t += 2) {
            const bool last = (t == nt - 2);
            const char* a1 = cA + (size_t)(t + 1) * kstep;
            const char* a2 = last ? nA : cA + (size_t)(t + 2) * kstep; const char* b2 = last ? nB : cB + (size_t)(t + 2) * kstep;
            const char* a3 = a2 + kstep; const char* b3 = b2 + kstep;
            if (last && has_next) S.a_ready(nxt);
            if constexpr (SP2) {
            PG8_LDB(B0, 0, 0); PG8_LDB(B1, 0, 1); PG8_SCHED; PG8_LDA(At, 0, 0); PG8_STAGE(PG8_SA(1, 1), a1 + hstep, voffA);
            PG8_WAIT_V(8); PG8_WAIT_L(0); PG8_BAR; PG8_MMA(0, 0, At, B0); PG8_MMA(0, 1, At, B1); PG8_BAR; PG8_SCHED;
            PG8_LDA(At, 0, 1); PG8_STAGE(PG8_SB(0, 0), b2, voffB); PG8_STAGE(PG8_SB(0, 1), b2 + hstep, voffB); PG8_STAGE(PG8_SA(0, 0), a2, voffA);
            PG8_WAIT_V(8); PG8_WAIT_L(0); PG8_BAR; PG8_MMA(1, 0, At, B0); PG8_MMA(1, 1, At, B1); PG8_BAR; PG8_SCHED;
            PG8_LDB(B0, 1, 0); PG8_LDB(B1, 1, 1); PG8_SCHED; PG8_LDA(At, 1, 0); PG8_STAGE(PG8_SA(0, 1), a2 + hstep, voffA);
            PG8_WAIT_V(8); PG8_WAIT_L(0); PG8_BAR; PG8_MMA(0, 0, At, B0); PG8_MMA(0, 1, At, B1); PG8_BAR; PG8_SCHED;
            PG8_LDA(At, 1, 1); PG8_STAGE(PG8_SB(1, 0), b3, voffB); PG8_STAGE(PG8_SB(1, 1), b3 + hstep, voffB); PG8_STAGE(PG8_SA(1, 0), a3, voffA);
            PG8_WAIT_V(8); PG8_WAIT_L(0); PG8_BAR; PG8_MMA(1, 0, At, B0); PG8_MMA(1, 1, At, B1); PG8_BAR; PG8_SCHED;
            } else {
            PG8_LDB(B0, 0, 0); PG8_SCHED; PG8_LDA(At, 0, 0); PG8_STAGE(PG8_SA(1, 1), a1 + hstep, voffA);
            PG8_WAIT_L(8); PG8_BAR; PG8_WAIT_L(0); PG8_MMA(0, 0, At, B0); PG8_BAR; PG8_SCHED;
            PG8_LDB(B1, 0, 1); PG8_STAGE(PG8_SB(0, 0), b2, voffB);
            PG8_BAR; PG8_WAIT_L(0); PG8_MMA(0, 1, At, B1); PG8_BAR;
            PG8_LDA(At, 0, 1); PG8_STAGE(PG8_SA(0, 0), a2, voffA);
            PG8_BAR; PG8_WAIT_L(0); PG8_MMA(1, 0, At, B0); PG8_BAR; PG8_SCHED;
            PG8_STAGE(PG8_SB(0, 1), b2 + hstep, voffB);
            PG8_WAIT_V(6); PG8_BAR; PG8_MMA(1, 1, At, B1); PG8_BAR;
            PG8_LDB(B0, 1, 0); PG8_SCHED; PG8_LDA(At, 1, 0); PG8_STAGE(PG8_SA(0, 1), a2 + hstep, voffA);
            PG8_WAIT_L(8); PG8_BAR; PG8_WAIT_L(0); PG8_MMA(0, 0, At, B0); PG8_BAR; PG8_SCHED;
            PG8_LDB(B1, 1, 1); PG8_STAGE(PG8_SB(1, 0), b3, voffB);
            PG8_BAR; PG8_WAIT_L(0); PG8_MMA(0, 1, At, B1); PG8_BAR;
            PG8_LDA(At, 1, 1); PG8_STAGE(PG8_SA(1, 0), a3, voffA);
            PG8_BAR; PG8_WAIT_L(0); PG8_MMA(1, 0, At, B0); PG8_BAR; PG8_SCHED;
            PG8_STAGE(PG8_SB(1, 1), b3 + hstep, voffB);
            PG8_WAIT_V(6); PG8_BAR; PG8_MMA(1, 1, At, B1); PG8_BAR;
            }
        }
        if constexpr (ALIGN_EPI) { if (wr == 0) PG8_BAR; }
        if constexpr (!Epi::AFTER_DRAIN) { E(acc, cur, wr, wc, fr, fq); S.done(cur); }
        if (!has_next) break;
#pragma unroll
        for (int a = 0; a < 2; ++a)
#pragma unroll
            for (int b = 0; b < 2; ++b)
#pragma unroll
                for (int m = 0; m < 4; ++m)
#pragma unroll
                    for (int n = 0; n < 2; ++n) acc[a][b][m][n] = (f32x4){0.f, 0.f, 0.f, 0.f};
        cur = nxt; cA = nA; cB = nB; ++ui;
        if constexpr (ALIGN_EPI) { if (wr == 1) PG8_BAR; }
    }
    PG8_WAIT_V(0);
    if constexpr (!ALIGN_EPI) { if (wr == 0) PG8_BAR; }
    PG8_BAR;
    if constexpr (Epi::AFTER_DRAIN) { E.fused(acc, cur, wr, wc, fr, fq, lds, wid, lane); S.done(cur); }
#undef PG8_SA
#undef PG8_SB
#undef PG8_STAGE
#undef PG8_LDA
#undef PG8_LDB
#undef PG8_MMA
#undef PG8_WAIT_V
#undef PG8_WAIT_L
#undef PG8_BAR
#undef PG8_SCHED
}
}

#define GAS __attribute__((address_space(1)))
#define LAS __attribute__((address_space(3)))
typedef unsigned short bf16;
typedef unsigned v4u __attribute__((ext_vector_type(4)));
typedef unsigned v2u __attribute__((ext_vector_type(2)));
typedef float f32x4 __attribute__((ext_vector_type(4)));
typedef short bf16x8 __attribute__((ext_vector_type(8)));

constexpr int D = 1024, MX = 32768, MC = 2048, MT = 34816;
constexpr int INC = 2576, DFF = 2816;
constexpr size_t MiB = 1u << 20;
constexpr size_t WS_WIN = 1 * MiB, WS_WOUT = 6 * MiB + MiB / 2, WS_WUP = 9 * MiB, WS_WDOWN = 20 * MiB + MiB / 2, WS_WP = 26 * MiB + MiB / 2;
constexpr size_t WS_MOD = 27 * MiB, WS_GATES = 28 * MiB;
constexpr size_t WS_XN = 32 * MiB;
constexpr size_t WS_QN = 32 * MiB, WS_KT = 66 * MiB;
constexpr size_t WS_P = 100 * MiB;
constexpr size_t P_SPLIT = (size_t)MT * 512;
constexpr size_t WS_OF = 100 * MiB, WS_OB = 134 * MiB;
constexpr size_t WS_WC = 270 * MiB, WS_UT = 338 * MiB, WS_AT = 406 * MiB, WS_YIN = 440 * MiB;
constexpr size_t WS_YX = 270 * MiB;
constexpr size_t WS_G = 96 * MiB, WS_U = 272 * MiB;
constexpr size_t WS_X1 = 448 * MiB;
constexpr size_t WS_Y2 = 32 * MiB;
constexpr size_t WS_EG = 504 * MiB, WS_SD = 506 * MiB, WS_EGL = 508 * MiB;
constexpr int LDS_CTL = 147456;
constexpr int LDS_CW = LDS_CTL + 1024;
constexpr int LDS_BYTES = LDS_CW + 7680;

struct Args { const float* in[21]; float* out; unsigned char* ws; int ph_lo, ph_hi; };

__device__ __forceinline__ unsigned f2bf(float f) { unsigned u = __builtin_bit_cast(unsigned, f); return (u + 0x7fffu + ((u >> 16) & 1u)) >> 16; }
typedef float f32x2_t __attribute__((ext_vector_type(2)));
typedef __bf16 bf16x2_t __attribute__((ext_vector_type(2)));
__device__ __forceinline__ unsigned pk2(float lo, float hi) { const f32x2_t v = {lo, hi}; return __builtin_bit_cast(unsigned, __builtin_convertvector(v, bf16x2_t)); }
__device__ __forceinline__ float bflo(unsigned u) { return __builtin_bit_cast(float, u << 16); }
__device__ __forceinline__ float bfhi(unsigned u) { return __builtin_bit_cast(float, u & 0xffff0000u); }
__device__ __forceinline__ float bf2f(bf16 h) { return __builtin_bit_cast(float, (unsigned)h << 16); }
__device__ __forceinline__ float wave_sum(float v) {
#pragma unroll
    for (int o = 1; o < 64; o <<= 1) v += __shfl_xor(v, o);
    return v;
}
__device__ __forceinline__ float sum16(float v) {
#pragma unroll
    for (int o = 1; o < 16; o <<= 1) v += __shfl_xor(v, o);
    return v;
}
__device__ __forceinline__ float silu_f(float v) { return v * __builtin_amdgcn_rcpf(1.f + __expf(-v)); }
__device__ __forceinline__ float rsq_f(float v) { return __builtin_amdgcn_rsqf(v); }
#define LDS_WAIT() asm volatile("s_waitcnt lgkmcnt(0)" ::: "memory")
#define LBAR() __syncthreads()
#define LBAR2() do { asm volatile("s_waitcnt lgkmcnt(0)" ::: "memory"); __builtin_amdgcn_s_barrier(); asm volatile("" ::: "memory"); } while (0)

__device__ __forceinline__ void tr_item(const float* W, int ldw, int c0, int K, bf16* WT, int r0, LAS float* scr, int kb, int nb, int lane) {
    const int k0 = 64 * kb, n0 = 32 * nb;
    float tv[32];
    const float* Wp_ = W + (size_t)(k0 + (lane >> 5)) * ldw + c0 + n0 + (lane & 31);
#pragma unroll
    for (int i = 0; i < 32; ++i) tv[i] = __builtin_nontemporal_load(Wp_ + (size_t)(2 * i) * ldw);
#pragma unroll
    for (int i = 0; i < 32; ++i) scr[(2 * i + (lane >> 5)) * 33 + (lane & 31)] = tv[i];
    LDS_WAIT(); asm volatile("" ::: "memory");
    const int c = lane & 7;
#pragma unroll
    for (int j = 0; j < 4; ++j) { const int n = (lane >> 3) + 8 * j; const LAS float* s = scr + (8 * c) * 33 + n;
        v4u o; o.x = pk2(s[0 * 33], s[1 * 33]); o.y = pk2(s[2 * 33], s[3 * 33]); o.z = pk2(s[4 * 33], s[5 * 33]); o.w = pk2(s[6 * 33], s[7 * 33]);
        *(v4u*)(WT + (size_t)(r0 + n0 + n) * K + k0 + 8 * c) = o; }
    LDS_WAIT(); asm volatile("" ::: "memory");
}

__device__ __forceinline__ void ph_prologue(const Args& a, LAS unsigned char* lds) {
    const int tid = threadIdx.x, lane = tid & 63, wave = tid >> 6;
    unsigned char* ws = a.ws;
    float* MOD = (float*)(ws + WS_MOD);
    for (int j = blockIdx.x; j < 192; j += gridDim.x) {
        LAS float* sc = (LAS float*)lds;
        LAS float* part = (LAS float*)(lds + 9 * 1024 * 4);
        { float cv[18];
#pragma unroll
          for (int i = 0; i < 18; ++i) { const int r = i >> 1, k = ((i & 1) << 9) + tid; cv[i] = r < 8 ? a.in[1][r * 1024 + k] : a.in[3][k]; }
#pragma unroll
          for (int i = 0; i < 18; ++i) sc[tid + 512 * i] = cv[i] / (1.f + expf(-cv[i])); }
        __syncthreads();
        const int kh = lane >> 5, col = lane & 31, n = j * 32 + col;
        float acc[9];
#pragma unroll
        for (int r = 0; r < 9; ++r) acc[r] = 0.f;
        const float* wm = a.in[4] + (size_t)kh * 6144 + n;
        for (int kc = wave * 128; kc < wave * 128 + 128; kc += 64) { float wv[32];
#pragma unroll
            for (int u = 0; u < 32; ++u) wv[u] = __builtin_nontemporal_load(wm + (size_t)(kc + 2 * u) * 6144);
#pragma unroll
            for (int u = 0; u < 32; ++u) {
#pragma unroll
                for (int r = 0; r < 9; ++r) acc[r] += sc[r * 1024 + kc + 2 * u + kh] * wv[u]; } }
#pragma unroll
        for (int r = 0; r < 9; ++r) { acc[r] += __shfl_xor(acc[r], 32); if (kh == 0) part[(wave * 9 + r) * 32 + col] = acc[r]; }
        __syncthreads();
        if (tid < 288) { const int r = tid >> 5, l2 = tid & 31; float s = a.in[5][j * 32 + l2];
#pragma unroll
            for (int w2 = 0; w2 < 8; ++w2) s += part[(w2 * 9 + r) * 32 + l2];
            MOD[r * 6144 + j * 32 + l2] = s; }
        __syncthreads();
    }
    LAS float* scr = (LAS float*)(lds + wave * 16384);
    const int gw = blockIdx.x * 8 + wave, NGW = gridDim.x * 8;
    for (int it = gw; it < 1312; it += NGW) {
        int r = it;
        if (r < 1024) { tr_item(a.in[10], INC, 0, 1024, (bf16*)(ws + WS_WIN), 0, scr, r / 64, r % 64, lane); continue; } r -= 1024;
        if (r < 256) { tr_item(a.in[10], INC, 2064, 1024, (bf16*)(ws + WS_WIN), 2048, scr, r / 16, r % 16, lane); continue; } r -= 256;
        { const int g = r >> 3, q = r & 7; tr_item(a.in[15] + g * 16384, 128, 0, 128, (bf16*)(ws + WS_WP) + g * 16384, 0, scr, q >> 2, q & 3, lane); }
    }
}
__device__ __forceinline__ void late_weights(const Args& a, LAS unsigned char* lds, int gw, int NGW) {
    const int lane = threadIdx.x & 63, wave = threadIdx.x >> 6;
    unsigned char* ws = a.ws;
    LAS float* scr = (LAS float*)(lds + wave * 16384);
    for (int it = gw; it < 4736; it += NGW) {
        int r = it;
        if (r < 512) { tr_item(a.in[17], 1024, 0, 1024, (bf16*)(ws + WS_WOUT), 0, scr, r / 32, r % 32, lane); continue; } r -= 512;
        if (r < 2816) { tr_item(a.in[18], 5632, 0, 1024, (bf16*)(ws + WS_WUP), 0, scr, r / 176, r % 176, lane); continue; } r -= 2816;
        tr_item(a.in[20], 1024, 0, 2816, (bf16*)(ws + WS_WDOWN), 0, scr, r / 32, r % 32, lane);
    }
}

__device__ __forceinline__ void norm1_row(const f32x4 (&A4)[4], const f32x4 (&B4)[4], bf16* XN, bf16* XNC, LAS bf16* hxs, int m, f32x4 (&v)[4], int lane) {
    float s = 0.f;
#pragma unroll
    for (int j = 0; j < 4; ++j) s += (v[j].x * v[j].x + v[j].y * v[j].y) + (v[j].z * v[j].z + v[j].w * v[j].w);
    const float rstd = rsq_f(wave_sum(s) * (1.f / D) + 1e-6f);
    v2u* o8 = (v2u*)(m < MX ? XN + (size_t)m * D : XNC + (size_t)(m - MX) * D) + lane;
#pragma unroll
    for (int j = 0; j < 4; ++j) { v[j] = v[j] * rstd * A4[j] + B4[j];
        v2u o; o.x = pk2(v[j].x, v[j].y); o.y = pk2(v[j].z, v[j].w); o8[64 * j] = o;
        *(LAS v2u*)(hxs + 4 * lane + 256 * j) = o; }
}
__device__ __forceinline__ void norm1_load(const Args& a, int m, f32x4 (&v)[4], int lane) {
    const float* xrow = m < MX ? a.in[0] + (size_t)m * D : a.in[2] + (size_t)(m - MX) * D;
#pragma unroll
    for (int j = 0; j < 4; ++j) v[j] = __builtin_nontemporal_load((const f32x4*)xrow + lane + 64 * j);
}
__device__ __forceinline__ void ph_norm1(const Args& a, LAS unsigned char* lds) {
    const int tid = threadIdx.x, lane = tid & 63, wave = tid >> 6;
    unsigned char* ws = a.ws;
    const float* MOD = (const float*)(ws + WS_MOD);
    float* GATES = (float*)(ws + WS_GATES);
    bf16* XN = (bf16*)(ws + WS_XN); bf16* XNC = (bf16*)(ws + WS_YIN);
    constexpr int WGS = 1032;
    LAS bf16* wgT = (LAS bf16*)lds;
    LAS bf16* hxs = (LAS bf16*)(lds + 16 * WGS * 2) + wave * (4 * WGS);
    { float tv[32]; const float* wsrc = a.in[10] + 2048 + (tid & 15) + (size_t)(tid >> 4) * INC;
#pragma unroll
      for (int i = 0; i < 32; ++i) tv[i] = wsrc[(size_t)(32 * i) * INC];
#pragma unroll
      for (int i = 0; i < 32; ++i) wgT[(tid & 15) * WGS + (tid >> 4) + 32 * i] = (bf16)pk2(tv[i], 0.f); }
    __syncthreads();
    const int r16 = lane & 15, q4 = lane >> 4;
    const int gw = blockIdx.x * 8 + wave, NGW = gridDim.x * 8;
    for (int m0 = gw * 4; m0 < MX; m0 += NGW * 4) {
        f32x4 va[4], vb[4], vc[4], vd[4];
        norm1_load(a, m0, va, lane); norm1_load(a, m0 + 1, vb, lane); norm1_load(a, m0 + 2, vc, lane); norm1_load(a, m0 + 3, vd, lane);
        const int mr = m0 >> 12;
        f32x4 A4[4], B4[4];
#pragma unroll
        for (int j = 0; j < 4; ++j) { const f32x4 g = ((const f32x4*)a.in[6])[lane + 64 * j], sc = ((const f32x4*)(MOD + mr * 6144 + 1024))[lane + 64 * j]; A4[j] = g * (sc + 1.0f); B4[j] = ((const f32x4*)(MOD + mr * 6144))[lane + 64 * j]; }
        norm1_row(A4, B4, XN, XNC, hxs, m0, va, lane);
        norm1_row(A4, B4, XN, XNC, hxs + WGS, m0 + 1, vb, lane);
        norm1_row(A4, B4, XN, XNC, hxs + 2 * WGS, m0 + 2, vc, lane);
        norm1_row(A4, B4, XN, XNC, hxs + 3 * WGS, m0 + 3, vd, lane);
        LDS_WAIT(); asm volatile("" ::: "memory");
        f32x4 acc = (f32x4){0.f, 0.f, 0.f, 0.f};
        const LAS bf16* ap = wgT + r16 * WGS + q4 * 8; const LAS bf16* bp = hxs + (r16 & 3) * WGS + q4 * 8;
#pragma unroll 8
        for (int ks = 0; ks < 32; ++ks) { const bf16x8 av = *(const LAS bf16x8*)(ap + ks * 32); const bf16x8 bv = *(const LAS bf16x8*)(bp + ks * 32); acc = __builtin_amdgcn_mfma_f32_16x16x32_bf16(av, bv, acc, 0, 0, 0); }
        if (r16 < 4) *(f32x4*)(GATES + (size_t)(m0 + r16) * 16 + q4 * 4) = acc;
        LDS_WAIT(); asm volatile("" ::: "memory");
    }
    for (int m = MX + gw; m < MT; m += NGW) {
        f32x4 va[4]; norm1_load(a, m, va, lane);
        f32x4 A4[4], B4[4];
#pragma unroll
        for (int j = 0; j < 4; ++j) { const f32x4 g = ((const f32x4*)a.in[6])[lane + 64 * j], sc = ((const f32x4*)(MOD + 8 * 6144 + 1024))[lane + 64 * j]; A4[j] = g * (sc + 1.0f); B4[j] = ((const f32x4*)(MOD + 8 * 6144))[lane + 64 * j]; }
        norm1_row(A4, B4, XN, XNC, hxs, m, va, lane);
        LDS_WAIT(); asm volatile("" ::: "memory");
        f32x4 acc = (f32x4){0.f, 0.f, 0.f, 0.f};
        const LAS bf16* ap = wgT + r16 * WGS + q4 * 8; const LAS bf16* bp = hxs + q4 * 8;
#pragma unroll 8
        for (int ks = 0; ks < 32; ++ks) { const bf16x8 av = *(const LAS bf16x8*)(ap + ks * 32); const bf16x8 bv = *(const LAS bf16x8*)(bp + ks * 32); acc = __builtin_amdgcn_mfma_f32_16x16x32_bf16(av, bv, acc, 0, 0, 0); }
        if (r16 == 0) *(f32x4*)(GATES + (size_t)m * 16 + q4 * 4) = acc;
        LDS_WAIT(); asm volatile("" ::: "memory");
    }
    __syncthreads();
}

constexpr int SQS = 136;
constexpr int TS = 72;
__device__ __forceinline__ void prep_load(const Args& a, int item, v4u (&ldv)[3][6]) {
    int tl = threadIdx.x; asm volatile("" : "+v"(tl));
    const int cgp = tl & 15, run = tl >> 4, i0 = 2 * run;
    int s, n, h, rowbase, T_;
    if (item < 2048) { h = item & 3; n = (item >> 2) & 63; s = item >> 8; rowbase = s * 4096; T_ = 4096; }
    else { const int r = item - 2048; h = r & 3; n = (r >> 2) & 3; s = r >> 4; rowbase = MX + s * 256; T_ = 256; }
    const bf16* P = (const bf16*)(a.ws + WS_P) + h * 128 + 8 * cgp;
#pragma unroll
    for (int X = 0; X < 3; ++X)
#pragma unroll
        for (int rr = 0; rr < 6; ++rr) { const int t = n * 64 + i0 - 2 + rr; ldv[X][rr] = (v4u){0u, 0u, 0u, 0u};
            if (t >= 0 && t < T_) ldv[X][rr] = __builtin_nontemporal_load((const v4u*)(P + (size_t)X * P_SPLIT + (size_t)(rowbase + t) * 512)); }
}
__device__ __forceinline__ void prep_item(const Args& a, LAS unsigned char* lds, int item, v4u (&ldv)[3][6], int next_item) {
    const int tid = threadIdx.x, lane = tid & 63, wave = tid >> 6;
    unsigned char* ws = a.ws;
    int s, n, h, rowbase, T_;
    const bool isx = item < 2048;
    if (isx) { h = item & 3; n = (item >> 2) & 63; s = item >> 8; rowbase = s * 4096; T_ = 4096; }
    else { const int r = item - 2048; h = r & 3; n = (r >> 2) & 3; s = r >> 4; rowbase = MX + s * 256; T_ = 256; }
    LAS bf16* sQ = (LAS bf16*)lds;
    LAS bf16* sK = (LAS bf16*)(lds + 17408);
    LAS bf16* sKT = (LAS bf16*)(lds + 34816);
    LAS bf16* sVT = (LAS bf16*)(lds + 53248);
    LAS float* Lm = (LAS float*)(lds + 71680);
    LAS float* Tm = (LAS float*)(lds + 108544);
    LAS float* gc = (LAS float*)(lds + 145408);
    LAS float* be = gc + 128;
    LAS float* egc = be + 128;
    const bf16* P = (const bf16*)(ws + WS_P);
    bf16* Qn = (bf16*)(ws + WS_QN) + (size_t)item * 8192;
    bf16* KT = (bf16*)(ws + WS_KT) + (size_t)item * 8192;
    if (gridDim.x & 3) {
        __syncthreads();
        for (int idx = tid; idx < 1920; idx += 512) { const int X = idx / 640, j = (idx / 128) % 5, c = idx & 127; ((LAS float*)(lds + LDS_CW))[idx] = a.in[11][j * 1536 + X * 512 + h * 128 + c]; }
        __syncthreads();
    }
    {
        int tl = tid; asm volatile("" : "+v"(tl));
        const int cgp = tl & 15, run = tl >> 4, i0 = 2 * run;
#pragma unroll
        for (int X = 0; X < 3; ++X) {
            float in[6][8];
#pragma unroll
            for (int rr = 0; rr < 6; ++rr) { const int t = n * 64 + i0 - 2 + rr;
                const v4u u = ldv[X][rr]; (void)t;
                in[rr][0] = bflo(u.x); in[rr][1] = bfhi(u.x); in[rr][2] = bflo(u.y); in[rr][3] = bfhi(u.y); in[rr][4] = bflo(u.z); in[rr][5] = bfhi(u.z); in[rr][6] = bflo(u.w); in[rr][7] = bfhi(u.w); }
            float o0[8], o1[8];
#pragma unroll
            for (int e = 0; e < 8; ++e) { o0[e] = 0.f; o1[e] = 0.f; }
            const LAS float* cw = (const LAS float*)(lds + LDS_CW) + X * 640 + 8 * cgp;
#pragma unroll
            for (int j = 0; j < 5; ++j) { const f32x4 w0 = *(const LAS f32x4*)(cw + j * 128), w1 = *(const LAS f32x4*)(cw + j * 128 + 4);
                const float w[8] = {w0.x, w0.y, w0.z, w0.w, w1.x, w1.y, w1.z, w1.w};
#pragma unroll
                for (int e = 0; e < 8; ++e) { o0[e] += w[e] * in[j][e]; o1[e] += w[e] * in[j + 1][e]; } }
            float s0 = 0.f, s1 = 0.f;
#pragma unroll
            for (int e = 0; e < 8; ++e) { o0[e] = silu_f(o0[e]); o1[e] = silu_f(o1[e]); s0 += o0[e] * o0[e]; s1 += o1[e] * o1[e]; }
            if (X < 2) { s0 = sum16(s0); s1 = sum16(s1);
                float r0 = rsq_f(s0 + 1e-6f), r1 = rsq_f(s1 + 1e-6f);
                if (X == 0) { r0 *= 0.08838834764831845f; r1 *= 0.08838834764831845f; }
#pragma unroll
                for (int e = 0; e < 8; ++e) { o0[e] *= r0; o1[e] *= r1; } }
            if (X < 2) {
                v4u w0, w1; w0.x = pk2(o0[0], o0[1]); w0.y = pk2(o0[2], o0[3]); w0.z = pk2(o0[4], o0[5]); w0.w = pk2(o0[6], o0[7]);
                w1.x = pk2(o1[0], o1[1]); w1.y = pk2(o1[2], o1[3]); w1.z = pk2(o1[4], o1[5]); w1.w = pk2(o1[6], o1[7]);
                LAS bf16* sX = X == 0 ? sQ : sK;
                *(LAS v4u*)(sX + i0 * SQS + 8 * cgp) = w0; *(LAS v4u*)(sX + (i0 + 1) * SQS + 8 * cgp) = w1;
                if (X == 0 && isx) { __builtin_nontemporal_store(w0, (v4u*)(Qn + i0 * 128 + 8 * cgp)); __builtin_nontemporal_store(w1, (v4u*)(Qn + (i0 + 1) * 128 + 8 * cgp)); }
            }
            if (X >= 1) { LAS bf16* sT = X == 1 ? sKT : sVT;
#pragma unroll
                for (int e = 0; e < 8; ++e) { const unsigned pr = pk2(o0[e], o1[e]); *(LAS unsigned*)(sT + (8 * cgp + e) * TS + ((((i0 >> 3) ^ (cgp & 7)) << 3) | (i0 & 7))) = pr; } }
        }
    }
    if (next_item >= 0) prep_load(a, next_item, ldv);
    if (wave < 2) {
        const int d = wave, ip = lane, tok = d ? 63 - ip : ip;
        const float* GATES = (const float*)(ws + WS_GATES) + (size_t)(rowbase + n * 64 + tok) * 16;
        const float ga = GATES[8 + 4 * d + h], gb = GATES[4 * d + h];
        const float A = expf(a.in[12][d * 4 + h]), dtb = a.in[13][d * 4 + h];
        const float xg = ga + dtb;
        const float sp = fmaxf(xg, 0.f) + log1pf(expf(-fabsf(xg)));
        float g = -A * sp;
        const float beta = 1.f / (1.f + expf(-gb));
#pragma unroll
        for (int off = 1; off < 64; off <<= 1) { const float t = __shfl_up(g, off); if (lane >= off) g += t; }
        const float glast = __shfl(g, 63);
        gc[d * 64 + ip] = g; be[d * 64 + ip] = beta; egc[d * 64 + ip] = expf(g);
        const int cidx = item * 2 + d;
        ((float*)(ws + WS_EG))[(size_t)cidx * 64 + ip] = expf(g);
        ((float*)(ws + WS_SD))[(size_t)cidx * 64 + ip] = expf(glast - g);
        if (lane == 63) ((float*)(ws + WS_EGL))[cidx] = expf(g);
    }
    LBAR2();
    {
        int ll = lane; asm volatile("" : "+v"(ll));
        const int r16 = ll & 15, q4 = ll >> 4;
#pragma unroll
        for (int tt = 0; tt < 4; ++tt) {
            const int T = wave * 4 + tt, which = T >> 4, mt = (T >> 2) & 3, nt = T & 3;
            const LAS bf16* sB = sK - which * (64 * SQS);
            f32x4 acc = (f32x4){0.f, 0.f, 0.f, 0.f};
#pragma unroll
            for (int ks = 0; ks < 4; ++ks) { const bf16x8 av = *(const LAS bf16x8*)(sK + (mt * 16 + r16) * SQS + ks * 32 + q4 * 8); const bf16x8 bv = *(const LAS bf16x8*)(sB + (nt * 16 + r16) * SQS + ks * 32 + q4 * 8);
                acc = __builtin_amdgcn_mfma_f32_16x16x32_bf16(av, bv, acc, 0, 0, 0); }
            const int c = nt * 16 + r16, cb = 63 - c, m0 = mt * 16 + q4 * 4;
            if (which == 0) {
#pragma unroll
                for (int j = 0; j < 4; ++j) { const int i = m0 + j, ib = 63 - i; const float v = acc[j];
                    Lm[i * TS + c] = (i > c) ? be[i] * v * __expf(gc[i] - gc[c]) : 0.f;
                    Lm[64 * TS + ib * TS + cb] = (ib > cb) ? be[64 + ib] * v * __expf(gc[64 + ib] - gc[64 + cb]) : 0.f; }
            } else if (isx) {
                float f[4], g[4];
#pragma unroll
                for (int j = 0; j < 4; ++j) { const int jj = m0 + j, jb = 63 - jj; const float v = acc[j];
                    f[j] = (c >= jj) ? v * __expf(gc[c] - gc[jj]) : 0.f;
                    g[j] = (cb >= jb) ? v * __expf(gc[64 + cb] - gc[64 + jb]) : 0.f; }
                LAS bf16* sAT = (LAS bf16*)Tm;
                v2u o; o.x = pk2(f[0], f[1]); o.y = pk2(f[2], f[3]); *(LAS v2u*)(sAT + c * 64 + (((m0 >> 3) ^ (c & 7)) << 3) + (m0 & 4)) = o;
                const int kb = 60 - m0;
                v2u p; p.x = pk2(g[3], g[2]); p.y = pk2(g[1], g[0]); *(LAS v2u*)(sAT + 4096 + cb * 64 + (((kb >> 3) ^ (cb & 7)) << 3) + (kb & 4)) = p;
            }
        }
    }
    LBAR2();
    if (isx) {
        int tl = tid; asm volatile("" : "+v"(tl));
#pragma unroll
        for (int k = 0; k < 2; ++k) { const int cc = tl + 512 * k, row = cc >> 3, ch = cc & 7;
            __builtin_nontemporal_store(*(const LAS v4u*)((const LAS bf16*)Tm + row * 64 + ((ch ^ (row & 7)) << 3)), (v4u*)((bf16*)(ws + WS_AT) + (size_t)(item * 2) * 4096 + cc * 8)); }
    }
    LBAR2();
    if (tid < 128) {
        int tl = tid; asm volatile("" : "+v"(tl));
        const int d = tl >> 6, k = (tl >> 4) & 3, c = tl & 15;
        const LAS float* Lb = Lm + d * (64 * TS) + (16 * k) * TS + 16 * k;
        LAS float* Tb = Tm + d * (64 * TS) + (16 * k) * TS + 16 * k;
        float x[16];
#pragma unroll
        for (int i = 0; i < 16; ++i) x[i] = (i == c) ? 1.f : 0.f;
#pragma unroll
        for (int i = 1; i < 16; ++i) { float acc = 0.f;
#pragma unroll
            for (int j = 0; j < i; ++j) acc += Lb[i * TS + j] * x[j];
            x[i] -= acc; }
#pragma unroll
        for (int i = 0; i < 16; ++i) Tb[i * TS + c] = x[i];
    } else {
        int tl = tid - 128; asm volatile("" : "+v"(tl));
#pragma unroll
        for (int k = 0; k < 3; ++k) { const int cc = tl + 384 * k;
            if (cc < 1024) { const int ln = cc & 63, krow = (cc >> 7) * 16 + (ln & 15), kch = ((cc >> 6) & 1) * 4 + (ln >> 4);
                __builtin_nontemporal_store(*(const LAS v4u*)(sKT + krow * TS + ((kch ^ ((krow >> 3) & 7)) << 3)), (v4u*)(KT + cc * 8)); } }
    }
    LBAR2();
    {
        int ll = lane; asm volatile("" : "+v"(ll));
        const int r16 = ll & 15, q4 = ll >> 4;
        const int d = wave >> 2, w = __builtin_amdgcn_readfirstlane(wave & 3);
        const LAS float* Ld = Lm + d * (64 * TS); LAS float* Td = Tm + d * (64 * TS);
        LAS float* tmp = (LAS float*)lds + d * 1920;
#define BLK(P, i, j) ((P) + (16 * (i)) * TS + 16 * (j))
#define TMPB(sl) (tmp + (sl) * 320)
#define MM16(acc, A, lda, B, ldb) do { _Pragma("unroll") for (int ks = 0; ks < 4; ++ks) (acc) = __builtin_amdgcn_mfma_f32_16x16x4f32((A)[r16 * (lda) + 4 * ks + q4], (B)[(4 * ks + q4) * (ldb) + r16], (acc), 0, 0, 0); } while (0)
#define ST16(P, ld, acc, sg) do { _Pragma("unroll") for (int j = 0; j < 4; ++j) (P)[(4 * q4 + j) * (ld) + r16] = (sg) * (acc)[j]; } while (0)
#define LD16(acc, P, ld) do { _Pragma("unroll") for (int j = 0; j < 4; ++j) (acc)[j] = (P)[(4 * q4 + j) * (ld) + r16]; } while (0)
        const f32x4 z4 = (f32x4){0.f, 0.f, 0.f, 0.f};
        f32x4 acc;
        if (w == 0) { acc = z4; MM16(acc, BLK(Ld, 1, 0), TS, BLK(Td, 0, 0), TS); ST16(TMPB(0), 20, acc, 1.f); acc = z4; MM16(acc, BLK(Ld, 3, 0), TS, BLK(Td, 0, 0), TS); ST16(TMPB(2), 20, acc, 1.f); }
        else if (w == 1) { acc = z4; MM16(acc, BLK(Ld, 2, 1), TS, BLK(Td, 1, 1), TS); ST16(TMPB(3), 20, acc, 1.f); acc = z4; MM16(acc, BLK(Ld, 3, 1), TS, BLK(Td, 1, 1), TS); ST16(TMPB(4), 20, acc, 1.f); }
        else if (w == 2) { acc = z4; MM16(acc, BLK(Ld, 3, 2), TS, BLK(Td, 2, 2), TS); ST16(TMPB(5), 20, acc, 1.f); }
        else { acc = z4; MM16(acc, BLK(Ld, 2, 0), TS, BLK(Td, 0, 0), TS); ST16(TMPB(1), 20, acc, 1.f); }
        LBAR2();
        if (w == 0) { acc = z4; MM16(acc, BLK(Td, 1, 1), TS, TMPB(0), 20); ST16(BLK(Td, 1, 0), TS, acc, -1.f); }
        else if (w == 1) { acc = z4; MM16(acc, BLK(Td, 2, 2), TS, TMPB(3), 20); ST16(BLK(Td, 2, 1), TS, acc, -1.f); }
        else if (w == 2) { acc = z4; MM16(acc, BLK(Td, 3, 3), TS, TMPB(5), 20); ST16(BLK(Td, 3, 2), TS, acc, -1.f); }
        LBAR2();
        if (w == 0) { LD16(acc, TMPB(1), 20); MM16(acc, BLK(Ld, 2, 1), TS, BLK(Td, 1, 0), TS); ST16(TMPB(1), 20, acc, 1.f); }
        else if (w == 1) { LD16(acc, TMPB(4), 20); MM16(acc, BLK(Ld, 3, 2), TS, BLK(Td, 2, 1), TS); ST16(TMPB(4), 20, acc, 1.f); }
        else if (w == 2) { LD16(acc, TMPB(2), 20); MM16(acc, BLK(Ld, 3, 1), TS, BLK(Td, 1, 0), TS); ST16(TMPB(2), 20, acc, 1.f); }
        LBAR2();
        if (w == 0) { acc = z4; MM16(acc, BLK(Td, 2, 2), TS, TMPB(1), 20); ST16(BLK(Td, 2, 0), TS, acc, -1.f);
            LDS_WAIT(); asm volatile("" ::: "memory");
            LD16(acc, TMPB(2), 20); MM16(acc, BLK(Ld, 3, 2), TS, BLK(Td, 2, 0), TS); ST16(TMPB(2), 20, acc, 1.f);
            LDS_WAIT(); asm volatile("" ::: "memory");
            acc = z4; MM16(acc, BLK(Td, 3, 3), TS, TMPB(2), 20); ST16(BLK(Td, 3, 0), TS, acc, -1.f); }
        else if (w == 1) { acc = z4; MM16(acc, BLK(Td, 3, 3), TS, TMPB(4), 20); ST16(BLK(Td, 3, 1), TS, acc, -1.f); }
#undef BLK
#undef TMPB
#undef MM16
#undef ST16
#undef LD16
    }
    LBAR2();
    {
        int tl = tid; asm volatile("" : "+v"(tl));
#pragma unroll
        for (int k = 0; k < 2; ++k) { const int gidx = tl + 512 * k, d = gidx >> 9, ip = (gidx >> 3) & 63, j8 = gidx & 7;
            const LAS float* Tr = Tm + d * (64 * TS) + ip * TS + 8 * j8;
            const f32x4 t0 = *(const LAS f32x4*)Tr, t1 = *(const LAS f32x4*)(Tr + 4);
            const f32x4 b0 = *(const LAS f32x4*)(be + d * 64 + 8 * j8), b1 = *(const LAS f32x4*)(be + d * 64 + 8 * j8 + 4);
            const f32x4 e0 = *(const LAS f32x4*)(egc + d * 64 + 8 * j8), e1 = *(const LAS f32x4*)(egc + d * 64 + 8 * j8 + 4);
            const bool up = (8 * j8) > (ip | 15);
            f32x4 u0 = t0 * b0, u1 = t1 * b1; if (up) { u0 = (f32x4){0.f, 0.f, 0.f, 0.f}; u1 = u0; }
            const f32x4 w0 = u0 * e0, w1 = u1 * e1;
            LAS bf16* Tu = (LAS bf16*)(Lm + d * (64 * TS)); LAS bf16* Tw = Tu + 64 * TS;
            v4u ou, ow; int pos;
            if (d) { ou.x = pk2(u1.w, u1.z); ou.y = pk2(u1.y, u1.x); ou.z = pk2(u0.w, u0.z); ou.w = pk2(u0.y, u0.x);
                     ow.x = pk2(w1.w, w1.z); ow.y = pk2(w1.y, w1.x); ow.z = pk2(w0.w, w0.z); ow.w = pk2(w0.y, w0.x); pos = 56 - 8 * j8; }
            else { ou.x = pk2(u0.x, u0.y); ou.y = pk2(u0.z, u0.w); ou.z = pk2(u1.x, u1.y); ou.w = pk2(u1.z, u1.w);
                   ow.x = pk2(w0.x, w0.y); ow.y = pk2(w0.z, w0.w); ow.z = pk2(w1.x, w1.y); ow.w = pk2(w1.z, w1.w); pos = 8 * j8; }
            asm volatile("" ::: "memory");
            *(LAS v4u*)(Tu + ip * TS + pos) = ou; *(LAS v4u*)(Tw + ip * TS + pos) = ow; }
    }
    LBAR2();
    {
        int ll = lane; asm volatile("" : "+v"(ll));
        const int r16 = ll & 15, q4 = ll >> 4;
        const int d = wave >> 2, rt = wave & 3;
        const LAS bf16* Tu = (const LAS bf16*)(Lm + d * (64 * TS)); const LAS bf16* Tw = Tu + 64 * TS;
        LAS bf16* sU = (LAS bf16*)lds + d * 8192;
        LAS bf16* sW = (LAS bf16*)Tm + d * 8192;
        bf16x8 tu[2], tw[2];
#pragma unroll
        for (int ks = 0; ks < 2; ++ks) { tu[ks] = *(const LAS bf16x8*)(Tu + (rt * 16 + r16) * TS + ks * 32 + q4 * 8); tw[ks] = *(const LAS bf16x8*)(Tw + (rt * 16 + r16) * TS + ks * 32 + q4 * 8); }
#pragma unroll
        for (int ct = 0; ct < 8; ++ct) {
            f32x4 au = (f32x4){0.f, 0.f, 0.f, 0.f}, aw = au;
#pragma unroll
            for (int ks = 0; ks < 2; ++ks) { const int swz_ = (((ks * 4 + q4) ^ ((2 * ct + (r16 >> 3)) & 7)) << 3); const bf16x8 vv = *(const LAS bf16x8*)(sVT + (ct * 16 + r16) * TS + swz_); const bf16x8 kv = *(const LAS bf16x8*)(sKT + (ct * 16 + r16) * TS + swz_);
                au = __builtin_amdgcn_mfma_f32_16x16x32_bf16(tu[ks], vv, au, 0, 0, 0);
                aw = __builtin_amdgcn_mfma_f32_16x16x32_bf16(kv, tw[ks], aw, 0, 0, 0); }
            { const int row = ct * 16 + r16, p0 = rt * 16 + q4 * 4;
              v2u o; o.x = pk2(au[0], au[1]); o.y = pk2(au[2], au[3]); *(LAS v2u*)(sU + row * 64 + (((p0 >> 3) ^ (row & 7)) << 3) + (p0 & 4)) = o; }
            { const int row = rt * 16 + r16, p0 = ct * 16 + q4 * 4;
              v2u p; p.x = pk2(aw[0], aw[1]); p.y = pk2(aw[2], aw[3]); *(LAS v2u*)(sW + row * 128 + (((p0 >> 3) ^ (row & 15)) << 3) + (p0 & 4)) = p; }
        }
    }
    LBAR2();
    {
        int tl = tid; asm volatile("" : "+v"(tl));
        bf16* Ut = (bf16*)(ws + WS_UT) + (size_t)(item * 2) * 8192; bf16* Wc = (bf16*)(ws + WS_WC) + (size_t)(item * 2) * 8192;
#pragma unroll
        for (int k = 0; k < 4; ++k) { const int cc = tl + 512 * k;
            { const int row = (cc >> 3) & 127, ch = cc & 7, dd = cc >> 10; const LAS bf16* sUd = (const LAS bf16*)lds + dd * 8192; const int u0 = (cc & 1023) * 2;
              v4u o; { const int un = u0, ln = un & 63, rw = ((un >> 6) & 7) * 16 + (ln & 15), ip = (un >> 9) * 16 + (ln >> 4) * 4; const v2u t = *(const LAS v2u*)(sUd + rw * 64 + (((ip >> 3) ^ (rw & 7)) << 3) + (ip & 4)); o.x = t.x; o.y = t.y; }
              { const int un = u0 + 1, ln = un & 63, rw = ((un >> 6) & 7) * 16 + (ln & 15), ip = (un >> 9) * 16 + (ln >> 4) * 4; const v2u t = *(const LAS v2u*)(sUd + rw * 64 + (((ip >> 3) ^ (rw & 7)) << 3) + (ip & 4)); o.z = t.x; o.w = t.y; }
              __builtin_nontemporal_store(o, (v4u*)(Ut + cc * 8)); }
            { const int f = cc & 1023, ln = f & 63, row = (f >> 8) * 16 + (ln & 15), ch = ((f >> 6) & 3) * 4 + (ln >> 4), dd = cc >> 10;
              __builtin_nontemporal_store(*(const LAS v4u*)((const LAS bf16*)Tm + dd * 8192 + row * 128 + ((ch ^ (row & 15)) << 3)), (v4u*)(Wc + cc * 8)); } }
    }
    LBAR2();
}

__device__ __forceinline__ void pool_item(const Args& a, LAS unsigned char* lds, int it) {
    const int tid = threadIdx.x, lane = tid & 63, wave = tid >> 6;
    unsigned char* ws = a.ws;
    const int r = it & 63, g = (it >> 6) & 3, b = it >> 8;
    const int w = 2 << g, left = w >> 1, right = w - 1 - left;
    const bf16* PP = (const bf16*)(ws + WS_P) + 4 * P_SPLIT + (size_t)b * 4096 * 512 + g * 128;
    LAS float* V = (LAS float*)lds;
    LAS bf16* sD = (LAS bf16*)(lds + 64 * 132 * 4);
    const int rlo = max(0, r - left), rhi = min(63, r + right);
    const float inv_r = 1.f / (float)(rhi - rlo + 1);
    float u[2][8];
#pragma unroll
    for (int k = 0; k < 2; ++k) { const int pr = tid + 512 * k, c = pr >> 4, cgp = pr & 15;
        float acc[8];
#pragma unroll
        for (int e = 0; e < 8; ++e) acc[e] = 0.f;
        v4u qv[16];
#pragma unroll
        for (int rr = 0; rr < 16; ++rr) { const int rp = rlo + rr; qv[rr] = (v4u){0u, 0u, 0u, 0u}; if (rp <= rhi) qv[rr] = *(const v4u*)(PP + (size_t)(rp * 64 + c) * 512 + 8 * cgp); }
#pragma unroll
        for (int rr = 0; rr < 16; ++rr) { const v4u q = qv[rr];
            const float f[8] = {bflo(q.x), bfhi(q.x), bflo(q.y), bfhi(q.y), bflo(q.z), bfhi(q.z), bflo(q.w), bfhi(q.w)};
#pragma unroll
            for (int e = 0; e < 8; ++e) acc[e] += f[e];
            if (rlo + rr == r) {
#pragma unroll
                for (int e = 0; e < 8; ++e) u[k][e] = f[e]; } }
        *(LAS f32x4*)(V + c * 132 + 8 * cgp) = (f32x4){acc[0] * inv_r, acc[1] * inv_r, acc[2] * inv_r, acc[3] * inv_r};
        *(LAS f32x4*)(V + c * 132 + 8 * cgp + 4) = (f32x4){acc[4] * inv_r, acc[5] * inv_r, acc[6] * inv_r, acc[7] * inv_r}; }
    LBAR();
#pragma unroll
    for (int k = 0; k < 2; ++k) { const int pr = tid + 512 * k, c = pr >> 4, cgp = pr & 15;
        const int clo = max(0, c - left), chi = min(63, c + right); const float inv_c = 1.f / (float)(chi - clo + 1);
        f32x4 m0 = (f32x4){0.f, 0.f, 0.f, 0.f}, m1 = m0;
        for (int cp = clo; cp <= chi; ++cp) { m0 += *(const LAS f32x4*)(V + cp * 132 + 8 * cgp); m1 += *(const LAS f32x4*)(V + cp * 132 + 8 * cgp + 4); }
        v4u o; o.x = pk2(m0.x * inv_c - u[k][0], m0.y * inv_c - u[k][1]); o.y = pk2(m0.z * inv_c - u[k][2], m0.w * inv_c - u[k][3]);
        o.z = pk2(m1.x * inv_c - u[k][4], m1.y * inv_c - u[k][5]); o.w = pk2(m1.z * inv_c - u[k][6], m1.w * inv_c - u[k][7]);
        *(LAS v4u*)(sD + c * 136 + 8 * cgp) = o; }
    LBAR();
    {
        const int r16 = lane & 15, q4 = lane >> 4, nt = wave;
        const bf16* Wp = (const bf16*)(ws + WS_WP) + g * 16384;
        bf16x8 bfr[4];
#pragma unroll
        for (int ks = 0; ks < 4; ++ks) bfr[ks] = *(const bf16x8*)(Wp + (nt * 16 + r16) * 128 + ks * 32 + q4 * 8);
        const float psc = a.in[16][g * 128 + nt * 16 + r16];
        LAS bf16* sY = (LAS bf16*)V;
#pragma unroll
        for (int mt = 0; mt < 4; ++mt) { f32x4 acc = (f32x4){0.f, 0.f, 0.f, 0.f};
#pragma unroll
            for (int ks = 0; ks < 4; ++ks) { const bf16x8 av = *(const LAS bf16x8*)(sD + (mt * 16 + r16) * 136 + ks * 32 + q4 * 8); acc = __builtin_amdgcn_mfma_f32_16x16x32_bf16(av, bfr[ks], acc, 0, 0, 0); }
#pragma unroll
            for (int j = 0; j < 4; ++j) sY[(mt * 16 + q4 * 4 + j) * 136 + nt * 16 + r16] = (bf16)pk2(acc[j] * psc, 0.f); }
    }
    LBAR();
    {
        bf16* YIN = (bf16*)(ws + WS_YIN) + (size_t)(b * 4096 + r * 64) * 1024 + 512 + g * 128;
#pragma unroll
        for (int k = 0; k < 2; ++k) { const int cc = tid + 512 * k; *(v4u*)(YIN + (size_t)(cc >> 4) * 1024 + (cc & 15) * 8) = *(const LAS v4u*)((const LAS bf16*)V + (cc >> 4) * 136 + (cc & 15) * 8); }
    }
    LBAR();
}

struct ScanFrag { bf16x8 aW[4], aK[2]; v2u u[2]; f32x4 sd; float egl; };
__device__ __forceinline__ int scan_cidx(int step, int b, int h, int d) {
    int item;
    if (step < 4) { const int n = d ? 3 - step : step; item = 2048 + (b * 4 + n) * 4 + h; }
    else { const int np = step - 4; const int n = d ? 63 - np : np; item = (b * 64 + n) * 4 + h; }
    return item * 2 + d;
}
__device__ __forceinline__ void scan_load(ScanFrag& f, const unsigned char* ws, int step, int b, int h, int d, int sl, int wave, int r16, int q4) {
    step = step < 68 ? step : 67;
    const int mt = wave >> 1, nh = wave & 1;
    const int cidx = scan_cidx(step, b, h, d), item = cidx >> 1;
    const bf16* Wc = (const bf16*)(ws + WS_WC) + (size_t)cidx * 8192;
    const bf16* Ut = (const bf16*)(ws + WS_UT) + (size_t)cidx * 8192;
    const bf16* KT = (const bf16*)(ws + WS_KT) + (size_t)item * 8192;
#pragma unroll
    for (int ks = 0; ks < 4; ++ks) f.aW[ks] = *(const bf16x8*)(Wc + (((mt * 4 + ks) * 64 + q4 * 16 + r16) << 3));
#pragma unroll
    for (int ks = 0; ks < 2; ++ks) f.aK[ks] = *(const bf16x8*)(KT + (((wave * 2 + ks) * 64 + q4 * 16 + r16) << 3));
#pragma unroll
    for (int t = 0; t < 2; ++t) f.u[t] = __builtin_nontemporal_load((const v2u*)(Ut + (((mt * 8 + sl * 4 + 2 * nh + t) * 64 + q4 * 16 + r16) << 2)));
    f.sd = *(const f32x4*)((const float*)(ws + WS_SD) + (size_t)cidx * 64 + mt * 16 + q4 * 4);
    f.egl = ((const float*)(ws + WS_EGL))[cidx];
}
template <bool IS_X>
__device__ __forceinline__ void scan_step(const ScanFrag& f, f32x4 (&accS)[4], unsigned char* ws, float* sn_base, int step, int b, int h, int d, int sl, int wave, int r16, int q4, LAS bf16* St, LAS bf16* Vt2) {
    LAS bf16* Vt = Vt2 + 64 * 72;
    const int mt = wave >> 1, nh = wave & 1, ip = mt * 16 + q4 * 4;
    const int cidx = scan_cidx(step, b, h, d);
#pragma unroll
    for (int t = 0; t < 2; ++t) {
        const int ncol = (2 * nh + t) * 16 + r16;
        f32x4 acc1 = (f32x4){0.f, 0.f, 0.f, 0.f};
#pragma unroll
        for (int ks = 0; ks < 4; ++ks) { const bf16x8 sb = *(const LAS bf16x8*)(St + ncol * 136 + ks * 32 + q4 * 8); acc1 = __builtin_amdgcn_mfma_f32_16x16x32_bf16(f.aW[ks], sb, acc1, 0, 0, 0); }
        const float v0 = bflo(f.u[t].x) - acc1[0], v1 = bfhi(f.u[t].x) - acc1[1], v2 = bflo(f.u[t].y) - acc1[2], v3 = bfhi(f.u[t].y) - acc1[3];
        if (IS_X) { v2u o; o.x = pk2(v0, v1); o.y = pk2(v2, v3); *(LAS v2u*)(Vt + ncol * 72 + ip) = o; }
        const float s0 = v0 * f.sd.x, s1 = v1 * f.sd.y, s2 = v2 * f.sd.z, s3 = v3 * f.sd.w;
        v2u o2;
        if (d) { o2.x = pk2(s3, s2); o2.y = pk2(s1, s0); *(LAS v2u*)(Vt2 + ncol * 72 + 60 - ip) = o2; }
        else { o2.x = pk2(s0, s1); o2.y = pk2(s2, s3); *(LAS v2u*)(Vt2 + ncol * 72 + ip) = o2; }
    }
    if (IS_X) { bf16* SN = (bf16*)sn_base + (size_t)cidx * 16384 + (size_t)sl * 8192;
        const int tid_ = wave * 64 + q4 * 16 + r16;
#pragma unroll
        for (int k = 0; k < 2; ++k) { const int c = tid_ + 512 * k, ln = c & 63, row = (c >> 8) * 16 + (ln & 15), ch = ((c >> 6) & 3) * 4 + (ln >> 4);
            __builtin_nontemporal_store(*(const LAS v4u*)(St + row * 136 + ch * 8), (v4u*)(SN + c * 8)); } }
    LBAR2();
    if (IS_X) { const int tid_ = wave * 64 + q4 * 16 + r16;
        const int ln = tid_ & 63, row = (tid_ >> 7) * 16 + (ln & 15), ch = ((tid_ >> 6) & 1) * 4 + (ln >> 4);
        __builtin_nontemporal_store(*(const LAS v4u*)(Vt + row * 72 + ch * 8), (v4u*)((bf16*)(ws + WS_OF) + (size_t)cidx * 8192 + (size_t)sl * 4096 + tid_ * 8)); }
#pragma unroll
    for (int n2 = 0; n2 < 4; ++n2) { accS[n2] = accS[n2] * f.egl;
#pragma unroll
        for (int ks = 0; ks < 2; ++ks) { const bf16x8 vb = *(const LAS bf16x8*)(Vt2 + (n2 * 16 + r16) * 72 + ks * 32 + q4 * 8); accS[n2] = __builtin_amdgcn_mfma_f32_16x16x32_bf16(f.aK[ks], vb, accS[n2], 0, 0, 0); }
        v2u o; o.x = pk2(accS[n2][0], accS[n2][1]); o.y = pk2(accS[n2][2], accS[n2][3]);
        *(LAS v2u*)(St + (n2 * 16 + r16) * 136 + wave * 16 + q4 * 4) = o; }
    LBAR2();
}

template <int MODE>
__device__ __forceinline__ void ph_scan(const Args& a, LAS unsigned char* lds, int nblk) {
    const int tid = threadIdx.x, lane = tid & 63, wave = tid >> 6, r16 = lane & 15, q4 = lane >> 4;
    unsigned char* ws = a.ws;
    LAS bf16* St = (LAS bf16*)lds;
    LAS bf16* Vt2 = St + 64 * 136;
    for (int wi = blockIdx.x; wi < 128; wi += nblk) {
        const int xcd = wi & 7, jq = wi >> 3; const int stream = xcd * 8 + (jq >> 1), sl = jq & 1;
        const int b = stream >> 3, h = (stream >> 1) & 3, d = stream & 1;
        for (int i = tid; i < 64 * 136 / 2; i += 512) ((LAS unsigned*)St)[i] = 0u;
        f32x4 accS[4];
#pragma unroll
        for (int n2 = 0; n2 < 4; ++n2) accS[n2] = (f32x4){0.f, 0.f, 0.f, 0.f};
        ScanFrag f0, f1, f2, f3;
        scan_load(f0, ws, 0, b, h, d, sl, wave, r16, q4);
        scan_load(f1, ws, 1, b, h, d, sl, wave, r16, q4);
        scan_load(f2, ws, 2, b, h, d, sl, wave, r16, q4);
        __syncthreads();
        {
            scan_load(f3, ws, 3, b, h, d, sl, wave, r16, q4); scan_step<false>(f0, accS, ws, a.out, 0, b, h, d, sl, wave, r16, q4, St, Vt2);
            scan_load(f0, ws, 4, b, h, d, sl, wave, r16, q4); scan_step<false>(f1, accS, ws, a.out, 1, b, h, d, sl, wave, r16, q4, St, Vt2);
            scan_load(f1, ws, 5, b, h, d, sl, wave, r16, q4); scan_step<false>(f2, accS, ws, a.out, 2, b, h, d, sl, wave, r16, q4, St, Vt2);
            scan_load(f2, ws, 6, b, h, d, sl, wave, r16, q4); scan_step<false>(f3, accS, ws, a.out, 3, b, h, d, sl, wave, r16, q4, St, Vt2);
        }
        for (int s4 = 4; s4 < 68; s4 += 4) {
            if (MODE != 2) scan_load(f3, ws, s4 + 3, b, h, d, sl, wave, r16, q4); scan_step<MODE == 0>(f0, accS, ws, a.out, s4, b, h, d, sl, wave, r16, q4, St, Vt2);
            if (MODE != 2) scan_load(f0, ws, s4 + 4, b, h, d, sl, wave, r16, q4); scan_step<MODE == 0>(f1, accS, ws, a.out, s4 + 1, b, h, d, sl, wave, r16, q4, St, Vt2);
            if (MODE != 2) scan_load(f1, ws, s4 + 5, b, h, d, sl, wave, r16, q4); scan_step<MODE == 0>(f2, accS, ws, a.out, s4 + 2, b, h, d, sl, wave, r16, q4, St, Vt2);
            if (MODE != 2) scan_load(f2, ws, s4 + 6, b, h, d, sl, wave, r16, q4); scan_step<MODE == 0>(f3, accS, ws, a.out, s4 + 3, b, h, d, sl, wave, r16, q4, St, Vt2);
        }
        asm volatile("s_waitcnt vmcnt(0)" ::: "memory");
        __syncthreads();
    }
}

constexpr int OUT_GRP = 73728;
__device__ __forceinline__ void out_pair(const Args& a, LAS unsigned char* lds0, int pair) {
    const int tid = threadIdx.x, lane = tid & 63, wave = tid >> 6, r16 = lane & 15, q4 = lane >> 4;
    const int grp = wave >> 2, wq = wave & 3, gt = tid & 255;
    unsigned char* ws = a.ws;
    const int item = pair * 2 + grp;
    const int h = item & 3, n = (item >> 2) & 63, b = item >> 8;
    LAS unsigned char* lds = lds0 + grp * OUT_GRP;
    LAS bf16* sQ = (LAS bf16*)lds;
    LAS bf16* sA = (LAS bf16*)(lds + 17408);
    LAS bf16* sZ = (LAS bf16*)(lds + 35840);
    LAS float* red = (LAS float*)(lds + 53248);
    LAS float* rinv = red + 256;
    LAS float* sEG = rinv + 64;
    const size_t trow = (size_t)b * 4096 + n * 64;
    v4u stq[4], sta[4], stz[4];
    {
        const bf16* Qn = (const bf16*)(ws + WS_QN) + (size_t)item * 8192;
        const bf16* AT = (const bf16*)(ws + WS_AT) + (size_t)(item * 2) * 4096;
        const bf16* PZ = (const bf16*)(ws + WS_P) + 3 * P_SPLIT + trow * 512 + h * 128;
#pragma unroll
        for (int k = 0; k < 4; ++k) { const int c = gt + 256 * k; stq[k] = __builtin_nontemporal_load((const v4u*)(Qn + c * 8)); sta[k] = __builtin_nontemporal_load((const v4u*)(AT + c * 8)); stz[k] = __builtin_nontemporal_load((const v4u*)(PZ + (size_t)(c >> 4) * 512 + (c & 15) * 8)); }
    }
    bf16x8 sb[2][2][4], vb[2][2][2];
#define OUT_LOAD_FRAGS(d) do { _Pragma("unroll") for (int t = 0; t < 2; ++t) { \
            const int cidx = item * 2 + (d), nt = 2 * wq + t; \
            const bf16* SN = (const bf16*)a.out + (size_t)cidx * 16384 + (((nt * 4) * 64 + q4 * 16 + r16) << 3); \
            const bf16* VN = (const bf16*)(ws + WS_OF) + (size_t)cidx * 8192 + (((nt * 2) * 64 + q4 * 16 + r16) << 3); \
            _Pragma("unroll") for (int ks = 0; ks < 4; ++ks) sb[d][t][ks] = __builtin_nontemporal_load((const bf16x8*)(SN + ks * 512)); \
            _Pragma("unroll") for (int ks = 0; ks < 2; ++ks) vb[d][t][ks] = __builtin_nontemporal_load((const bf16x8*)(VN + ks * 512)); } } while (0)
    OUT_LOAD_FRAGS(0);
    float egv = 0.f;
    if (gt < 128) egv = ((const float*)(ws + WS_EG))[(size_t)(item * 2) * 64 + gt];
    {
#pragma unroll
        for (int k = 0; k < 4; ++k) { const int c = gt + 256 * k;
            *(LAS v4u*)(sQ + (c >> 4) * 136 + (c & 15) * 8) = stq[k];
            *(LAS v4u*)(sA + (c >> 3) * 72 + (c & 7) * 8) = sta[k];
            *(LAS v4u*)(sZ + (c >> 4) * 136 + (c & 15) * 8) = stz[k]; }
        if (gt < 128) sEG[gt] = egv;
    }
    asm volatile("" ::: "memory");
    OUT_LOAD_FRAGS(1);
#undef OUT_LOAD_FRAGS
    __syncthreads();
    f32x4 o[2][4];
#pragma unroll
    for (int t = 0; t < 2; ++t)
#pragma unroll
        for (int mt = 0; mt < 4; ++mt) o[t][mt] = (f32x4){0.f, 0.f, 0.f, 0.f};
#pragma unroll
    for (int d = 0; d < 2; ++d) {
#pragma unroll
        for (int mt = 0; mt < 4; ++mt) {
            bf16x8 qa[4], aa[2];
#pragma unroll
            for (int ks = 0; ks < 4; ++ks) qa[ks] = *(const LAS bf16x8*)(sQ + (mt * 16 + r16) * 136 + ks * 32 + q4 * 8);
            const int arow = d ? 63 - (mt * 16 + r16) : (mt * 16 + r16);
#pragma unroll
            for (int ks = 0; ks < 2; ++ks) aa[ks] = *(const LAS bf16x8*)(sA + (d * 64 + arow) * 72 + ks * 32 + q4 * 8);
            const int t0 = mt * 16 + q4 * 4;
            f32x4 eg;
            if (d) { const f32x4 e = *(const LAS f32x4*)(sEG + 64 + 60 - t0); eg = (f32x4){e.w, e.z, e.y, e.x}; } else eg = *(const LAS f32x4*)(sEG + t0);
#pragma unroll
            for (int t = 0; t < 2; ++t) {
                f32x4 aq = (f32x4){0.f, 0.f, 0.f, 0.f};
#pragma unroll
                for (int ks = 0; ks < 4; ++ks) aq = __builtin_amdgcn_mfma_f32_16x16x32_bf16(qa[ks], sb[d][t][ks], aq, 0, 0, 0);
                f32x4 acc = aq * eg;
#pragma unroll
                for (int ks = 0; ks < 2; ++ks) acc = __builtin_amdgcn_mfma_f32_16x16x32_bf16(aa[ks], vb[d][t][ks], acc, 0, 0, 0);
                o[t][mt] += acc;
            }
            asm volatile("" ::: "memory");
        }
    }
#pragma unroll
    for (int mt = 0; mt < 4; ++mt)
#pragma unroll
        for (int j = 0; j < 4; ++j) { float p = o[0][mt][j] * o[0][mt][j] + o[1][mt][j] * o[1][mt][j]; p = sum16(p); if (r16 == 0) red[wq * 64 + mt * 16 + q4 * 4 + j] = p; }
    __syncthreads();
    if (gt < 64) { const float t = (red[gt] + red[64 + gt]) + (red[128 + gt] + red[192 + gt]); rinv[gt] = rsq_f(t * (1.f / 128.f) + 1e-6f); }
    __syncthreads();
#pragma unroll
    for (int t = 0; t < 2; ++t) {
        const int v = (2 * wq + t) * 16 + r16; const float onw = a.in[14][v];
#pragma unroll
        for (int mt = 0; mt < 4; ++mt)
#pragma unroll
            for (int j = 0; j < 4; ++j) { const int tk = mt * 16 + q4 * 4 + j; const float z = bf2f(sZ[tk * 136 + v]);
                sQ[tk * 136 + v] = (bf16)pk2(o[t][mt][j] * rinv[tk] * onw * silu_f(z), 0.f); }
    }
    __syncthreads();
    {
        bf16* YIN = (bf16*)(ws + WS_YIN) + trow * 1024 + h * 128;
#pragma unroll
        for (int k = 0; k < 4; ++k) { const int c = gt + 256 * k; *(v4u*)(YIN + (size_t)(c >> 4) * 1024 + (c & 15) * 8) = *(const LAS v4u*)(sQ + (c >> 4) * 136 + (c & 15) * 8); }
    }
    __syncthreads();
}

__device__ __forceinline__ void ph_mid(const Args& a) {
    const int tid = threadIdx.x, lane = tid & 63, wave = tid >> 6;
    unsigned char* ws = a.ws;
    const float* MOD = (const float*)(ws + WS_MOD);
    const bf16* YX = (const bf16*)(ws + WS_YX);
    bf16* XN2 = (bf16*)(ws + WS_XN);
    const int gw = blockIdx.x * 8 + wave, NGW = gridDim.x * 8;
    constexpr int R = 2;
    for (int t0 = gw * R; t0 < MX; t0 += NGW * R) {
        const int b = t0 >> 12;
        f32x4 xv[R][4]; v2u yv[R][4];
#pragma unroll
        for (int r = 0; r < R; ++r)
#pragma unroll
            for (int j = 0; j < 4; ++j) { xv[r][j] = __builtin_nontemporal_load((const f32x4*)(a.in[0] + (size_t)(t0 + r) * D) + lane + 64 * j); yv[r][j] = __builtin_nontemporal_load((const v2u*)(YX + (size_t)(t0 + r) * D) + lane + 64 * j); }
        f32x4 G1[4], GT[4], A2[4], B2[4];
#pragma unroll
        for (int j = 0; j < 4; ++j) { G1[j] = ((const f32x4*)a.in[7])[lane + 64 * j]; GT[j] = ((const f32x4*)(MOD + b * 6144 + 2048))[lane + 64 * j];
            const f32x4 g = ((const f32x4*)a.in[8])[lane + 64 * j], sc = ((const f32x4*)(MOD + b * 6144 + 4096))[lane + 64 * j]; A2[j] = g * (sc + 1.0f); B2[j] = ((const f32x4*)(MOD + b * 6144 + 3072))[lane + 64 * j]; }
#pragma unroll
        for (int r = 0; r < R; ++r) {
            const int t = t0 + r;
            f32x4 y[4]; float s = 0.f;
#pragma unroll
            for (int j = 0; j < 4; ++j) { const v2u q = yv[r][j]; y[j] = (f32x4){bflo(q.x), bfhi(q.x), bflo(q.y), bfhi(q.y)}; s += (y[j].x * y[j].x + y[j].y * y[j].y) + (y[j].z * y[j].z + y[j].w * y[j].w); }
            const float r1 = rsq_f(wave_sum(s) * (1.f / D) + 1e-6f);
            f32x4 x1[4]; float s2 = 0.f;
            v2u* orow = (v2u*)((bf16*)(ws + WS_X1) + (size_t)t * D) + lane;
#pragma unroll
            for (int j = 0; j < 4; ++j) { x1[j] = xv[r][j] + GT[j] * (y[j] * r1 * G1[j]); { v2u ob; ob.x = pk2(x1[j].x, x1[j].y); ob.y = pk2(x1[j].z, x1[j].w); __builtin_nontemporal_store(ob, orow + 64 * j); }
                s2 += (x1[j].x * x1[j].x + x1[j].y * x1[j].y) + (x1[j].z * x1[j].z + x1[j].w * x1[j].w); }
            const float r2 = rsq_f(wave_sum(s2) * (1.f / D) + 1e-6f);
            v2u* o8 = (v2u*)(XN2 + (size_t)t * D) + lane;
#pragma unroll
            for (int j = 0; j < 4; ++j) { const f32x4 hv = x1[j] * r2 * A2[j] + B2[j]; v2u o; o.x = pk2(hv.x, hv.y); o.y = pk2(hv.z, hv.w); o8[64 * j] = o; }
        }
    }
}

template <int NCG>
__device__ __forceinline__ void ph_act(const Args& a) {
    unsigned char* ws = a.ws;
    const bf16* G = (const bf16*)(ws + WS_G); bf16* U = (bf16*)(ws + WS_U);
    const int gt = blockIdx.x * 512 + threadIdx.x, NT = gridDim.x * 512;
    constexpr int RUN = 8;
    for (int it = gt; it < (MX / RUN) * NCG; it += NT) {
        const int cgp = it % NCG, run = it / NCG, t0 = run * RUN;
        const bf16* gp = G + (size_t)t0 * DFF + 8 * cgp; bf16* up = U + (size_t)t0 * DFF + 8 * cgp;
        v4u gv[RUN + 2], uv[RUN];
        gv[0] = (v4u){0u, 0u, 0u, 0u}; gv[RUN + 1] = (v4u){0u, 0u, 0u, 0u};
        if ((t0 & 4095) != 0) gv[0] = *(const v4u*)(gp - DFF);
        if (((t0 + RUN) & 4095) != 0) gv[RUN + 1] = *(const v4u*)(gp + (size_t)RUN * DFF);
#pragma unroll
        for (int i = 0; i < RUN; ++i) { gv[i + 1] = *(const v4u*)(gp + (size_t)i * DFF); uv[i] = *(const v4u*)(up + (size_t)i * DFF); }
        const float* cw = a.in[19] + 8 * cgp;
        float w[3][8];
#pragma unroll
        for (int j = 0; j < 3; ++j) { const f32x4 w0 = *(const f32x4*)(cw + j * DFF), w1 = *(const f32x4*)(cw + j * DFF + 4); w[j][0] = w0.x; w[j][1] = w0.y; w[j][2] = w0.z; w[j][3] = w0.w; w[j][4] = w1.x; w[j][5] = w1.y; w[j][6] = w1.z; w[j][7] = w1.w; }
#pragma unroll
        for (int i = 0; i < RUN; ++i) {
            const v4u prev = gv[i], curv = gv[i + 1], nx = gv[i + 2], uu = uv[i];
            const float p[8] = {bflo(prev.x), bfhi(prev.x), bflo(prev.y), bfhi(prev.y), bflo(prev.z), bfhi(prev.z), bflo(prev.w), bfhi(prev.w)};
            const float c[8] = {bflo(curv.x), bfhi(curv.x), bflo(curv.y), bfhi(curv.y), bflo(curv.z), bfhi(curv.z), bflo(curv.w), bfhi(curv.w)};
            const float q[8] = {bflo(nx.x), bfhi(nx.x), bflo(nx.y), bfhi(nx.y), bflo(nx.z), bfhi(nx.z), bflo(nx.w), bfhi(nx.w)};
            const float uf[8] = {bflo(uu.x), bfhi(uu.x), bflo(uu.y), bfhi(uu.y), bflo(uu.z), bfhi(uu.z), bflo(uu.w), bfhi(uu.w)};
            float r[8];
#pragma unroll
            for (int e = 0; e < 8; ++e) r[e] = silu_f(w[0][e] * p[e] + w[1][e] * c[e] + w[2][e] * q[e]) * uf[e];
            v4u o; o.x = pk2(r[0], r[1]); o.y = pk2(r[2], r[3]); o.z = pk2(r[4], r[5]); o.w = pk2(r[6], r[7]);
            *(v4u*)(up + (size_t)i * DFF) = o;
        }
    }
}

__device__ __forceinline__ void ph_final(const Args& a) {
    const int tid = threadIdx.x, lane = tid & 63, wave = tid >> 6;
    unsigned char* ws = a.ws;
    const float* MOD = (const float*)(ws + WS_MOD);
    const bf16* Y2 = (const bf16*)(ws + WS_Y2);
    const int gw = blockIdx.x * 8 + wave, NGW = gridDim.x * 8;
    constexpr int R = 4;
    for (int t0 = gw * R; t0 < MX; t0 += NGW * R) {
        const int b = t0 >> 12;
        f32x4 xv[R][4]; v2u yv[R][4];
#pragma unroll
        for (int r = 0; r < R; ++r)
#pragma unroll
            for (int j = 0; j < 4; ++j) { const v2u xb = __builtin_nontemporal_load((const v2u*)((const bf16*)(ws + WS_X1) + (size_t)(t0 + r) * D) + lane + 64 * j); xv[r][j] = (f32x4){bflo(xb.x), bfhi(xb.x), bflo(xb.y), bfhi(xb.y)}; yv[r][j] = __builtin_nontemporal_load((const v2u*)(Y2 + (size_t)(t0 + r) * D) + lane + 64 * j); }
        f32x4 GG[4];
#pragma unroll
        for (int j = 0; j < 4; ++j) GG[j] = ((const f32x4*)a.in[9])[lane + 64 * j] * ((const f32x4*)(MOD + b * 6144 + 5120))[lane + 64 * j];
#pragma unroll
        for (int r = 0; r < R; ++r) {
            f32x4 y[4]; float s = 0.f;
#pragma unroll
            for (int j = 0; j < 4; ++j) { const v2u q = yv[r][j]; y[j] = (f32x4){bflo(q.x), bfhi(q.x), bflo(q.y), bfhi(q.y)}; s += (y[j].x * y[j].x + y[j].y * y[j].y) + (y[j].z * y[j].z + y[j].w * y[j].w); }
            const float r1 = rsq_f(wave_sum(s) * (1.f / D) + 1e-6f);
            f32x4* orow = (f32x4*)(a.out + (size_t)(t0 + r) * D) + lane;
#pragma unroll
            for (int j = 0; j < 4; ++j) __builtin_nontemporal_store(xv[r][j] + GG[j] * (y[j] * r1), orow + 64 * j);
        }
    }
}

typedef GAS unsigned gu32;
#define XB_TMO      128
#define XB_XCNT(j)  (256  + 64 * (j))
#define XB_XSUB(j)  (1280 + 64 * (j))
#define XB_XGEN(j)  (2304 + 64 * (j))
#define XB_TOP      3328
#define XB_TOPGEN   3392
#define XCD_BAR_WORDS 3456
#define XB_SPIN_CAP (1u << 18)

__device__ __forceinline__ unsigned xb_ld(unsigned* p)              { return __hip_atomic_load(p, __ATOMIC_RELAXED, __HIP_MEMORY_SCOPE_AGENT); }
__device__ __forceinline__ unsigned xb_add(unsigned* p, unsigned v) { return __hip_atomic_fetch_add(p, v, __ATOMIC_RELAXED, __HIP_MEMORY_SCOPE_AGENT); }
__device__ __forceinline__ unsigned xb_xcc_id() { return (unsigned)__builtin_amdgcn_s_getreg((3 << 11) | 20) & 0xFu; }
#define XB_SPIN(cond, bar) do { unsigned _sp = 0; while (cond) { __builtin_amdgcn_s_sleep(1); \
    if ((++_sp & 255u) == 0u) { if (xb_ld(&(bar)[XB_TMO])) break; if (_sp > XB_SPIN_CAP) { atomicAdd(&(bar)[XB_TMO], 1u); break; } } } } while (0)

struct XcdBarrier {
    unsigned* bar; unsigned x;
    volatile LAS unsigned* st;
};

__device__ __forceinline__ XcdBarrier xcd_barrier_post(unsigned* bar, volatile LAS unsigned* st) {
    XcdBarrier b; b.bar = bar; b.x = xb_xcc_id(); b.st = st;
    if (threadIdx.x == 0) (void)xb_add(&bar[XB_XCNT(b.x)], 1u);
    return b;
}
__device__ __forceinline__ void xcd_barrier_complete(unsigned* bar, unsigned x, unsigned& nloc, unsigned& nx) {
    const unsigned G = gridDim.x * gridDim.y * gridDim.z;
    unsigned sum, cnt, mine, sp = 0u;
    for (;;) {
        sum = 0u; cnt = 0u; mine = 0u;
#pragma unroll
        for (unsigned j = 0; j < 16; ++j) { const unsigned c = xb_ld(&bar[XB_XCNT(j)]); sum += c; cnt += (c > 0u) ? 1u : 0u; mine = (j == x) ? c : mine; }
        if (sum == G) break;
        __builtin_amdgcn_s_sleep(1);
        if ((++sp & 255u) == 0u) { if (xb_ld(&bar[XB_TMO])) break; if (sp > XB_SPIN_CAP) { atomicAdd(&bar[XB_TMO], 1u); break; } }
    }
    nloc = mine > 0u ? mine : 1u; nx = cnt > 0u ? cnt : 1u;
}

__device__ __forceinline__ void xcd_barrier(const XcdBarrier& b) {
    asm volatile("s_waitcnt vmcnt(0)" ::: "memory");
    __syncthreads();
    if (threadIdx.x == 0) {
        unsigned* bar = b.bar;
        __builtin_amdgcn_s_waitcnt(0);
        unsigned nloc = b.st[0], nx = b.st[1];
        if (nloc == 0u) { xcd_barrier_complete(bar, b.x, nloc, nx); b.st[0] = nloc; b.st[1] = nx; }
        const unsigned old = xb_add(&bar[XB_XSUB(b.x)], 1u);
        const unsigned gen = old / nloc;
        if (old + 1u == (gen + 1u) * nloc) {
            __builtin_amdgcn_fence(__ATOMIC_RELEASE, "agent");
            asm volatile("s_waitcnt vmcnt(0)" ::: "memory");
            const unsigned og = xb_add(&bar[XB_TOP], 1u);
            const unsigned tg = og / nx;
            if (og + 1u == (tg + 1u) * nx) xb_add(&bar[XB_TOPGEN], 1u);
            else XB_SPIN(xb_ld(&bar[XB_TOPGEN]) == tg, bar);
            __builtin_amdgcn_fence(__ATOMIC_ACQUIRE, "agent");
            xb_add(&bar[XB_XGEN(b.x)], 1u);
            asm volatile("s_waitcnt vmcnt(0)" ::: "memory");
        } else {
            XB_SPIN(xb_ld(&bar[XB_XGEN(b.x)]) == gen, bar);
            __builtin_amdgcn_fence(__ATOMIC_ACQUIRE, "agent");
            asm volatile("s_waitcnt vmcnt(0)" ::: "memory");
        }
    }
    __syncthreads();
}

constexpr int NPH = 12;
__global__ void __launch_bounds__(512, 2) mega_fwd(Args a) {
    extern __shared__ __attribute__((aligned(16))) unsigned char lds_raw[];
    LAS unsigned char* lds = (LAS unsigned char*)lds_raw;
    cg::grid_group grid = cg::this_grid();
    unsigned char* ws = a.ws;
    if (threadIdx.x < 64) ((LAS unsigned*)(lds + LDS_CTL))[threadIdx.x] = 0u;
    __syncthreads();
    XcdBarrier bar = xcd_barrier_post((unsigned*)ws, (volatile LAS unsigned*)(lds + LDS_CTL + 64));
    const int lo = a.ph_lo, hi = a.ph_hi;
#ifndef PHMASK
#define PHMASK 0xFFF
#endif
#define IN(k) (((PHMASK >> (k)) & 1) && lo <= (k) && (k) < hi)
#ifndef DUP_MASK
#define DUP_MASK 0
#endif
#define REP(k) for (int rep_ = 0; rep_ < ((((DUP_MASK) >> (k)) & 1) ? 2 : 1); ++rep_)
#define REPBAR() do { if (rep_) xcd_barrier(bar); } while (0)
#define SEAM(k) do { if (IN(k) && IN((k) + 1)) xcd_barrier(bar); } while (0)
    if (a.ph_lo < 0) grid.sync();
    if (IN(0)) REP(0) { REPBAR(); ph_prologue(a, lds); }
    SEAM(0);
    if (IN(1)) REP(1) { REPBAR(); ph_norm1(a, lds); }
    SEAM(1);
    if (IN(2)) REP(2) {   REPBAR();
        pg8::Gemm g{(const bf16*)(ws + WS_XN), (const bf16*)(ws + WS_WIN), MX, 2560, 1024}; pg8::StaticOrder S; S.init(MX, 2560, (int)gridDim.x, (int)blockIdx.x);
        pg8::EpiBf16<0> E{(bf16*)(ws + WS_P), 512, nullptr, 512, P_SPLIT, 1.f};
        pg8::gemm_phase<pg8::EpiBf16<0>, pg8::StaticOrder, true, true>(lds, g, S, E);
    }
    SEAM(2);
    if (IN(3)) REP(3) { REPBAR();
#ifndef P3_PREP_REPS
#define P3_PREP_REPS 1
#endif
#ifndef P3_POOL_REPS
#define P3_POOL_REPS 1
#endif
        unsigned* cflag = (unsigned*)ws + 3600;
        const int G = (int)gridDim.x, bid = (int)blockIdx.x;
        const bool cw_lds = (G & 3) == 0;
        if (cw_lds) { for (int idx = threadIdx.x; idx < 1920; idx += 512) { const int X = idx / 640, j = (idx / 128) % 5, c = idx & 127; ((LAS float*)(lds + LDS_CW))[idx] = a.in[11][j * 1536 + X * 512 + (bid & 3) * 128 + c]; } __syncthreads(); }
        if (G >= 160) {
            if (bid < 32) {
                pg8::Gemm g{(const bf16*)(ws + WS_YIN), (const bf16*)(ws + WS_WIN) + (size_t)512 * 1024, MC, 1024, 1024}; pg8::StaticOrder S; S.init(MC, 1024, 32, bid);
                pg8::EpiBf16<0> E{(bf16*)(ws + WS_P) + P_SPLIT + (size_t)MX * 512, 512, nullptr, 512, P_SPLIT, 1.f};
                pg8::gemm_phase<pg8::EpiBf16<0>, pg8::StaticOrder, true, true>(lds, g, S, E);
                __threadfence(); __syncthreads();
                if (threadIdx.x == 0) __hip_atomic_fetch_add(cflag, 1u, __ATOMIC_RELEASE, __HIP_MEMORY_SCOPE_AGENT);
            }
            {
              const bool rebal = (G == 256);
              const int xlim = (rebal && bid < 32) ? 1792 : 2048;
              const int extra = (rebal && bid >= 160 && bid < 192) ? 1792 + (bid - 160) : -1;
              v4u ldv[3][6]; prep_load(a, bid, ldv);
              for (int it = bid; it < xlim; it += G) prep_item(a, lds, it, ldv, it + G < xlim ? it + G : extra);
              if (extra >= 0) prep_item(a, lds, extra, ldv, -1); }
            for (int it = bid - 32; it >= 0 && it < 128; it += G) {
                if (threadIdx.x == 0) { unsigned sp = 0; while (__hip_atomic_load(cflag, __ATOMIC_RELAXED, __HIP_MEMORY_SCOPE_AGENT) < 32u && ++sp < (1u << 22)) __builtin_amdgcn_s_sleep(4); }
                __syncthreads();
                __builtin_amdgcn_fence(__ATOMIC_ACQUIRE, "agent");
                { v4u ldv[3][6]; prep_load(a, 2048 + it, ldv); prep_item(a, lds, 2048 + it, ldv, -1); }
            }
        } else {
            for (int u0 = bid; u0 < 32; u0 += G) {
                pg8::Gemm g{(const bf16*)(ws + WS_YIN), (const bf16*)(ws + WS_WIN) + (size_t)512 * 1024, MC, 1024, 1024}; pg8::StaticOrder S; S.init(MC, 1024, 32, u0);
                pg8::EpiBf16<0> E{(bf16*)(ws + WS_P) + P_SPLIT + (size_t)MX * 512, 512, nullptr, 512, P_SPLIT, 1.f};
                pg8::gemm_phase<pg8::EpiBf16<0>, pg8::StaticOrder, true, true>(lds, g, S, E);
            }
            xcd_barrier(bar);
            for (int it = bid; it < 2176; it += G) { v4u ldv[3][6]; prep_load(a, it, ldv); prep_item(a, lds, it, ldv, -1); }
        }
    }
    SEAM(3);
#ifndef SCAN_PROBE_MODE
#define SCAN_PROBE_MODE 0
#endif
    if (IN(4)) REP(4) { REPBAR();
        const int G = (int)gridDim.x, nscan = G >= 256 ? 128 : G;
        if ((int)blockIdx.x < nscan) { if (rep_ == 0) ph_scan<0>(a, lds, nscan); else ph_scan<SCAN_PROBE_MODE>(a, lds, nscan); }
        if (G < 256 || (int)blockIdx.x >= nscan) {
            const int ob = G >= 256 ? (int)blockIdx.x - nscan : (int)blockIdx.x, on = G >= 256 ? G - nscan : G;
            for (int it = ob; it < 2048; it += on) pool_item(a, lds, it);
            late_weights(a, lds, ob * 8 + (int)(threadIdx.x >> 6), on * 8);
        }
    }
    SEAM(4);
    if (IN(5)) REP(5) { REPBAR(); for (int it = blockIdx.x; it < 1024; it += gridDim.x) out_pair(a, lds, it); }
    SEAM(5);
    if (IN(6)) REP(6) {   REPBAR();
        pg8::Gemm g{(const bf16*)(ws + WS_YIN), (const bf16*)(ws + WS_WOUT), MX, 1024, 1024}; pg8::StaticOrder S; S.init(MX, 1024, (int)gridDim.x, (int)blockIdx.x);
        pg8::EpiBf16<0> E{(bf16*)(ws + WS_YX), 1024, nullptr, 0, 0, 1.f};
        pg8::gemm_phase<pg8::EpiBf16<0>, pg8::StaticOrder, true, true>(lds, g, S, E);
    }
    SEAM(6);
    if (IN(7)) REP(7) { REPBAR(); ph_mid(a); }
    SEAM(7);
    if (IN(8)) REP(8) {   REPBAR();
        pg8::Gemm g{(const bf16*)(ws + WS_XN), (const bf16*)(ws + WS_WUP), MX, DFF + 256, 1024}; pg8::StaticOrder S; S.init(MX, DFF + 256, (int)gridDim.x, (int)blockIdx.x);
        pg8::EpiBf16<0> E{(bf16*)(ws + WS_G), DFF, nullptr, DFF, (size_t)(WS_U - WS_G) / 2, 1.f};
        pg8::gemm_phase<pg8::EpiBf16<0>, pg8::StaticOrder, true, true>(lds, g, S, E);
    }
    SEAM(8);
    if (IN(9)) {
        ph_act<32>(a);
        pg8::Gemm g{(const bf16*)(ws + WS_XN), (const bf16*)(ws + WS_WUP) + (size_t)(DFF + 256) * 1024, MX, DFF - 256, 1024}; pg8::StaticOrder S; S.init(MX, DFF - 256, (int)gridDim.x, (int)blockIdx.x);
        pg8::EpiAct E{(const bf16*)(ws + WS_G) + 256, (bf16*)(ws + WS_U) + 256, DFF, a.in[19] + 256};
        pg8::gemm_phase<pg8::EpiAct, pg8::StaticOrder, true, true>(lds, g, S, E);
    }
    SEAM(9);
    if (IN(10)) REP(10) {  REPBAR();
        pg8::Gemm g{(const bf16*)(ws + WS_U), (const bf16*)(ws + WS_WDOWN), MX, 1024, DFF}; pg8::StaticOrder S; S.init(MX, 1024, (int)gridDim.x, (int)blockIdx.x);
        pg8::EpiBf16<0> E{(bf16*)(ws + WS_Y2), 1024, nullptr, 0, 0, 1.f};
        pg8::gemm_phase<pg8::EpiBf16<0>, pg8::StaticOrder, true, true>(lds, g, S, E);
    }
    SEAM(10);
    if (IN(11)) ph_final(a);
#undef IN
#undef SEAM
}

#ifndef MK_LAUNCHES
#define MK_LAUNCHES 1
#endif
extern "C" void kernel_launch(void* const* d_in, const int* in_sizes, int n_in, void* d_out, int out_size, void* d_ws, size_t ws_size, hipStream_t stream) {
    static int grid = 0;
    if (grid == 0) {
        int dev = 0, cus = 0, per_cu = 0;
        hipGetDevice(&dev);
        hipDeviceGetAttribute(&cus, hipDeviceAttributeMultiprocessorCount, dev);
        if (hipFuncSetAttribute((const void*)mega_fwd, hipFuncAttributeMaxDynamicSharedMemorySize, LDS_BYTES) != hipSuccess) { fprintf(stderr, "kernel_launch: hipFuncSetAttribute failed\n"); grid = -1; return; }
        if (hipOccupancyMaxActiveBlocksPerMultiprocessor(&per_cu, (const void*)mega_fwd, 512, LDS_BYTES) != hipSuccess || per_cu < 1) { fprintf(stderr, "kernel_launch: occupancy query failed (%d)\n", per_cu); per_cu = 1; }
        (void)hipGetLastError();
        grid = cus * 1;
        if (per_cu < 1 || cus < 1) grid = -1;
        if (ws_size < (size_t)512 * MiB) { fprintf(stderr, "kernel_launch: workspace too small: %zu\n", ws_size); grid = -1; }
    }
    if (grid < 0) return;
    if (hipMemsetAsync(d_ws, 0, 16384, stream) != hipSuccess) { fprintf(stderr, "kernel_launch: memset failed\n"); return; }
    Args a{};
    for (int i = 0; i < 21; ++i) a.in[i] = (const float*)d_in[i];
    a.out = (float*)d_out; a.ws = (unsigned char*)d_ws;
#if MK_LAUNCHES == 1
    a.ph_lo = 0; a.ph_hi = NPH;
    void* args[] = {&a};
    hipError_t e = hipLaunchCooperativeKernel((const void*)mega_fwd, dim3(grid), dim3(512), args, LDS_BYTES, stream);
    if (e != hipSuccess) fprintf(stderr, "cooperative launch failed: %s (grid %d)\n", hipGetErrorString(e), grid);
#else
    for (int p = 0; p < NPH; ++p) { a.ph_lo = p; a.ph_hi = p + 1; hipLaunchKernelGGL(mega_fwd, dim3(grid), dim3(512), LDS_BYTES, stream, a); }
#endif
}
```

```cpp
#include <hip/hip_runtime.h>
#include <hip/hip_cooperative_groups.h>
#include <cstdio>
#include <cstdint>
namespace cg = cooperative_groups;
namespace pg8 {
#define PG8_LAS __attribute__((address_space(3)))
typedef unsigned short bf16_t;
typedef short bf16x8 __attribute__((ext_vector_type(8)));
typedef float f32x4 __attribute__((ext_vector_type(4)));
typedef unsigned u32x4 __attribute__((ext_vector_type(4)));
constexpr int BM = 256, BK = 64, HALF = 128, HTB = HALF * BK * 2  , STAGE_BYTES = 8 * HTB, NXCD = 8, WGM = 8;

__host__ __device__ __forceinline__ int lds_byte(int r, int c) { const int st = (r >> 4) * 2 + (c >> 5), rr = r & 15, cc = c & 31, ob = rr * 64 + cc * 2; return st * 1024 + (ob ^ (((ob >> 9) & 1) << 5)); }
__host__ __device__ __forceinline__ void stage_rc(int b, int& R, int& C) { const int st = b / 1024, sb = b % 1024, swz = sb ^ (((sb >> 9) & 1) << 5); R = (st >> 1) * 16 + swz / 64; C = (st & 1) * 32 + (swz % 64) / 2; }
__host__ __device__ __forceinline__ int perm32(int rho) { const int n = rho >> 4, i = rho & 15; return 8 * (i >> 2) + 4 * n + (i & 3); }

struct Unit { int pm, pn; };
struct Gemm { const bf16_t* A; const bf16_t* Bt; int M, N, K; };

struct StaticOrder {
    int nM, nN, nwg, G, c;
    __host__ __device__ void init(int M, int N, int G_, int c_) { nM = M / BM; nN = N / BM; nwg = nM * nN; G = G_; c = c_; }
    __host__ __device__ bool next(int i, Unit& u) const {
        const long L = (long)i * G + c; if (L >= nwg) return false;
        int wgid = (int)L; { const int q = nwg / NXCD, r = nwg % NXCD, xcd = wgid % NXCD, off = wgid / NXCD; wgid = (xcd < r ? xcd * (q + 1) : r * (q + 1) + (xcd - r) * q) + off; }
        const int nig = WGM * nN, gid = wgid / nig, fm = gid * WGM, gsz = (nM - fm) < WGM ? (nM - fm) : WGM;
        u.pm = fm + ((wgid % nig) % gsz); u.pn = (wgid % nig) / gsz; return true;
    }
    __device__ __forceinline__ void a_ready(const Unit&) const {}
    __device__ __forceinline__ void done(const Unit&) const {}
};

typedef __bf16 pg8_bf16x2 __attribute__((ext_vector_type(2)));
__device__ __forceinline__ unsigned cvt_pk_bf16(float lo, float hi) { typedef float f2_ __attribute__((ext_vector_type(2))); const f2_ v = {lo, hi}; return __builtin_bit_cast(unsigned, __builtin_convertvector(v, pg8_bf16x2)); }
typedef float f32x2 __attribute__((ext_vector_type(2)));
__device__ __forceinline__ f32x2 gelu_pk(f32x2 v) {
    const f32x2 av = __builtin_elementwise_abs(v), d = av * 0.2316418882f + 1.0f;
    f32x2 t; t.x = __builtin_amdgcn_rcpf(d.x); t.y = __builtin_amdgcn_rcpf(d.y);
    f32x2 q = t * 0.5307027145f + (-0.7265760135f); q = q * t + 0.7107068705f; q = q * t + (-0.142248368f); q = q * t + 0.127414796f; q = q * t;
    const f32x2 s = (v * v) * (-0.72134752044f);
    f32x2 e; e.x = __builtin_amdgcn_exp2f(s.x); e.y = __builtin_amdgcn_exp2f(s.y);
    const f32x2 m = v * (q * e), r = v - m;
    f32x2 o; o.x = v.x < 0.f ? m.x : r.x; o.y = v.y < 0.f ? m.y : r.y; return o;
}

template <int ACT  > struct EpiBf16 {
    static constexpr bool PERM = true, AFTER_DRAIN = false; static_assert(ACT == 0 || ACT == 1, "EpiBf16: ACT is 0 (none) or 1 (gelu_pk)");
    bf16_t* O; int ldc; const float* bias; int split_cols; size_t split_stride; float scale0;
    __device__ __forceinline__ void operator()(const f32x4 (&acc)[2][2][4][2], const Unit& u, int wr, int wc, int fr, int fq) const {
        const int row0 = u.pm * BM + wr * 64 + fr; int colt = u.pn * BM; bf16_t* base = O;
        float sc = 1.f; if (split_cols) { const int t = colt / split_cols; base += (size_t)t * split_stride; colt -= t * split_cols; if (t == 0) sc = scale0; }
        const int col0 = colt + wc * 32 + 8 * fq, bcol0 = u.pn * BM + wc * 32 + 8 * fq;
        f32x4 bv[2][2];
#pragma unroll
        for (int bj = 0; bj < 2; ++bj)
#pragma unroll
            for (int n = 0; n < 2; ++n) bv[bj][n] = bias ? *(const f32x4*)(bias + bcol0 + bj * HALF + 4 * n) : (f32x4){0.f, 0.f, 0.f, 0.f};
#pragma unroll
        for (int ai = 0; ai < 2; ++ai)
#pragma unroll
            for (int m = 0; m < 4; ++m) { bf16_t* rowp = base + (size_t)(row0 + ai * HALF + m * 16) * ldc + col0;
#pragma unroll
                for (int bj = 0; bj < 2; ++bj) { f32x4 v0 = acc[ai][bj][m][0] + bv[bj][0], v1 = acc[ai][bj][m][1] + bv[bj][1];
                    if (ACT == 1) { f32x2 a = gelu_pk((f32x2){v0[0], v0[1]}), b = gelu_pk((f32x2){v0[2], v0[3]}), c = gelu_pk((f32x2){v1[0], v1[1]}), d = gelu_pk((f32x2){v1[2], v1[3]});
                        v0 = (f32x4){a.x, a.y, b.x, b.y}; v1 = (f32x4){c.x, c.y, d.x, d.y}; }
                    v0 = v0 * sc; v1 = v1 * sc; u32x4 w; w.x = cvt_pk_bf16(v0[0], v0[1]); w.y = cvt_pk_bf16(v0[2], v0[3]); w.z = cvt_pk_bf16(v1[0], v1[1]); w.w = cvt_pk_bf16(v1[2], v1[3]);
                    *(u32x4*)(rowp + bj * HALF) = w; } }
    }
};
struct EpiAct {
    static constexpr bool PERM = true, AFTER_DRAIN = false;
    const bf16_t* G; bf16_t* O; int ldc; const float* cw;
    __device__ __forceinline__ void operator()(const f32x4 (&acc)[2][2][4][2], const Unit& u, int wr, int wc, int fr, int fq) const {
        const int row0 = u.pm * BM + wr * 64 + fr, col0 = u.pn * BM + wc * 32 + 8 * fq;
#pragma unroll
        for (int bj = 0; bj < 2; ++bj) {
            const int c = col0 + bj * HALF;
            float w[3][8];
#pragma unroll
            for (int j = 0; j < 3; ++j) { const f32x4 w0 = *(const f32x4*)(cw + (size_t)j * ldc + c), w1 = *(const f32x4*)(cw + (size_t)j * ldc + c + 4);
                w[j][0] = w0[0]; w[j][1] = w0[1]; w[j][2] = w0[2]; w[j][3] = w0[3]; w[j][4] = w1[0]; w[j][5] = w1[1]; w[j][6] = w1[2]; w[j][7] = w1[3]; }
#pragma unroll
            for (int ai = 0; ai < 2; ++ai)
#pragma unroll
                for (int m = 0; m < 4; ++m) {
                    const int r = row0 + ai * HALF + m * 16;
                    const bf16_t* gp = G + (size_t)r * ldc + c;
                    u32x4 pv = (u32x4){0u, 0u, 0u, 0u}, nv = pv;
                    if ((r & 4095) != 0) pv = *(const u32x4*)(gp - ldc);
                    if (((r + 1) & 4095) != 0) nv = *(const u32x4*)(gp + ldc);
                    const u32x4 cv = *(const u32x4*)gp;
                    const f32x4 v0 = acc[ai][bj][m][0], v1 = acc[ai][bj][m][1];
                    const float up[8] = {v0[0], v0[1], v0[2], v0[3], v1[0], v1[1], v1[2], v1[3]};
                    float o[8];
#pragma unroll
                    for (int q = 0; q < 4; ++q) {
                        const float p0 = __builtin_bit_cast(float, pv[q] << 16), p1 = __builtin_bit_cast(float, pv[q] & 0xffff0000u);
                        const float c0 = __builtin_bit_cast(float, cv[q] << 16), c1 = __builtin_bit_cast(float, cv[q] & 0xffff0000u);
                        const float n0 = __builtin_bit_cast(float, nv[q] << 16), n1 = __builtin_bit_cast(float, nv[q] & 0xffff0000u);
                        const float s0 = w[0][2 * q] * p0 + w[1][2 * q] * c0 + w[2][2 * q] * n0, s1 = w[0][2 * q + 1] * p1 + w[1][2 * q + 1] * c1 + w[2][2 * q + 1] * n1;
                        o[2 * q] = s0 * __builtin_amdgcn_rcpf(1.f + __expf(-s0)) * up[2 * q]; o[2 * q + 1] = s1 * __builtin_amdgcn_rcpf(1.f + __expf(-s1)) * up[2 * q + 1]; }
                    u32x4 wv; wv.x = cvt_pk_bf16(o[0], o[1]); wv.y = cvt_pk_bf16(o[2], o[3]); wv.z = cvt_pk_bf16(o[4], o[5]); wv.w = cvt_pk_bf16(o[6], o[7]);
                    *(u32x4*)(O + (size_t)r * ldc + c) = wv;
                }
        }
    }
};

template <class Epi, class Sched, bool ALIGN_EPI = false, bool SP2 = false>
__device__ __forceinline__ void gemm_phase(PG8_LAS unsigned char* lds, const Gemm g, const Sched& S, const Epi& E) {
    const int tid = threadIdx.x, wid = __builtin_amdgcn_readfirstlane(tid >> 6), lane = tid & 63, wr = wid >> 2, wc = wid & 3, fr = lane & 15, fq = lane >> 4;
    const int K = g.K, nt = K / BK;
    unsigned voffA[2], voffB[2];
#pragma unroll
    for (int i = 0; i < 2; ++i) { int R, C; stage_rc(tid * 16 + i * 8192, R, C); const int Rb = Epi::PERM ? ((R & ~31) + perm32(R & 31)) : R;
        voffA[i] = (unsigned)(R * K + C) * 2u; voffB[i] = (unsigned)(Rb * K + C) * 2u; }
    const size_t kstep = (size_t)(BK * 2);
    const size_t hstep = (size_t)HALF * K * 2;
    const size_t tstep = 2 * hstep;
    const unsigned ldsw = (unsigned)wid * 1024u;
    const int aoff = lds_byte(wr * 64 + fr, fq * 8), boff = lds_byte(wc * 32 + fr, fq * 8);
#define PG8_SA(b, h) (((b) * 2 + (h)) * HTB)
#define PG8_SB(b, h) ((4 + (b) * 2 + (h)) * HTB)
#define PG8_STAGE(bufoff, gbase, voff) do { _Pragma("unroll") for (int _i = 0; _i < 2; ++_i) \
        __builtin_amdgcn_global_load_lds((const unsigned*)((const char*)(gbase) + (voff)[_i]), (PG8_LAS unsigned*)(lds + (bufoff) + ldsw + _i * 8192), 16, 0, 0); } while (0)
#define PG8_LDA(dst, b, h) do { _Pragma("unroll") for (int m = 0; m < 4; ++m) _Pragma("unroll") for (int k = 0; k < 2; ++k) dst[m][k] = *(const PG8_LAS bf16x8*)(lds + PG8_SA(b, h) + aoff + m * 2048 + k * 1024); } while (0)
#define PG8_LDB(dst, b, h) do { _Pragma("unroll") for (int n = 0; n < 2; ++n) _Pragma("unroll") for (int k = 0; k < 2; ++k) dst[n][k] = *(const PG8_LAS bf16x8*)(lds + PG8_SB(b, h) + boff + n * 2048 + k * 1024); } while (0)
#define PG8_MMA(ai, bj, At, Bt) do { __builtin_amdgcn_s_setprio(1); _Pragma("unroll") for (int m = 0; m < 4; ++m) _Pragma("unroll") for (int n = 0; n < 2; ++n) _Pragma("unroll") for (int k = 0; k < 2; ++k) \
        acc[ai][bj][m][n] = __builtin_amdgcn_mfma_f32_16x16x32_bf16(Bt[n][k], At[m][k], acc[ai][bj][m][n], 0, 0, 0); __builtin_amdgcn_s_setprio(0); } while (0)
#define PG8_WAIT_V(n) asm volatile("s_waitcnt vmcnt(" #n ")" ::: "memory")
#define PG8_WAIT_L(n) asm volatile("s_waitcnt lgkmcnt(" #n ")" ::: "memory")
#define PG8_BAR __builtin_amdgcn_s_barrier()
#define PG8_SCHED __builtin_amdgcn_sched_barrier(0)
    Unit cur, nxt; int ui = 0;
    if (!S.next(0, cur)) return;
    f32x4 acc[2][2][4][2];
#pragma unroll
    for (int a = 0; a < 2; ++a)
#pragma unroll
        for (int b = 0; b < 2; ++b)
#pragma unroll
            for (int m = 0; m < 4; ++m)
#pragma unroll
                for (int n = 0; n < 2; ++n) acc[a][b][m][n] = (f32x4){0.f, 0.f, 0.f, 0.f};
    bf16x8 At[4][2], B0[2][2], B1[2][2];
    const char* cA = (const char*)g.A + (size_t)cur.pm * tstep; const char* cB = (const char*)g.Bt + (size_t)cur.pn * tstep;
    S.a_ready(cur);
    if constexpr (SP2) {
        PG8_STAGE(PG8_SB(0, 0), cB, voffB); PG8_STAGE(PG8_SB(0, 1), cB + hstep, voffB); PG8_STAGE(PG8_SA(0, 0), cA, voffA); PG8_STAGE(PG8_SA(0, 1), cA + hstep, voffA);
        if (wr == 1) PG8_BAR;
        PG8_WAIT_V(2); PG8_BAR;
        PG8_STAGE(PG8_SB(1, 0), cB + kstep, voffB); PG8_STAGE(PG8_SA(1, 0), cA + kstep, voffA); PG8_STAGE(PG8_SB(1, 1), cB + hstep + kstep, voffB);
        PG8_WAIT_V(6); PG8_BAR;
    } else {
        PG8_STAGE(PG8_SB(0, 0), cB, voffB); PG8_STAGE(PG8_SA(0, 0), cA, voffA); PG8_STAGE(PG8_SB(0, 1), cB + hstep, voffB); PG8_STAGE(PG8_SA(0, 1), cA + hstep, voffA);
        if (wr == 1) PG8_BAR;
        PG8_WAIT_V(4); PG8_BAR;
        PG8_STAGE(PG8_SB(1, 0), cB + kstep, voffB); PG8_STAGE(PG8_SA(1, 0), cA + kstep, voffA); PG8_STAGE(PG8_SB(1, 1), cB + hstep + kstep, voffB);
        PG8_WAIT_V(6); PG8_BAR;
    }
    for (;;) {
        const bool has_next = S.next(ui + 1, nxt);
        const char* nA = has_next ? (const char*)g.A + (size_t)nxt.pm * tstep : cA; const char* nB = has_next ? (const char*)g.Bt + (size_t)nxt.pn * tstep : cB;
        for (int t = 0; t < nt; t += 2) {
            const bool last = (t == nt - 2);
            const char* a1 = cA + (size_t)(t + 1) * kstep;
            const char* a2 = last ? nA : cA + (size_t)(t + 2) * kstep; const char* b2 = last ? nB : cB + (size_t)(t + 2) * kstep;
            const char* a3 = a2 + kstep; const char* b3 = b2 + kstep;
            if (last && has_next) S.a_ready(nxt);
            if constexpr (SP2) {
            PG8_LDB(B0, 0, 0); PG8_LDB(B1, 0, 1); PG8_SCHED; PG8_LDA(At, 0, 0); PG8_STAGE(PG8_SA(1, 1), a1 + hstep, voffA);
            PG8_WAIT_V(8); PG8_WAIT_L(0); PG8_BAR; PG8_MMA(0, 0, At, B0); PG8_MMA(0, 1, At, B1); PG8_BAR; PG8_SCHED;
            PG8_LDA(At, 0, 1); PG8_STAGE(PG8_SB(0, 0), b2, voffB); PG8_STAGE(PG8_SB(0, 1), b2 + hstep, voffB); PG8_STAGE(PG8_SA(0, 0), a2, voffA);
            PG8_WAIT_V(8); PG8_WAIT_L(0); PG8_BAR; PG8_MMA(1, 0, At, B0); PG8_MMA(1, 1, At, B1); PG8_BAR; PG8_SCHED;
            PG8_LDB(B0, 1, 0); PG8_LDB(B1, 1, 1); PG8_SCHED; PG8_LDA(At, 1, 0); PG8_STAGE(PG8_SA(0, 1), a2 + hstep, voffA);
            PG8_WAIT_V(8); PG8_WAIT_L(0); PG8_BAR; PG8_MMA(0, 0, At, B0); PG8_MMA(0, 1, At, B1); PG8_BAR; PG8_SCHED;
            PG8_LDA(At, 1, 1); PG8_STAGE(PG8_SB(1, 0), b3, voffB); PG8_STAGE(PG8_SB(1, 1), b3 + hstep, voffB); PG8_STAGE(PG8_SA(1, 0), a3, voffA);
            PG8_WAIT_V(8); PG8_WAIT_L(0); PG8_BAR; PG8_MMA(1, 0, At, B0); PG8_MMA(1, 1, At, B1); PG8_BAR; PG8_SCHED;
            } else {
            PG8_LDB(B0, 0, 0); PG8_SCHED; PG8_LDA(At, 0, 0); PG8_STAGE(PG8_SA(1, 1), a1 + hstep, voffA);
            PG8_WAIT_L(8); PG8_BAR; PG8_WAIT_L(0); PG8_MMA(0, 0, At, B0); PG8_BAR; PG8_SCHED;
            PG8_LDB(B1, 0, 1); PG8_STAGE(PG8_SB(0, 0), b2, voffB);
            PG8_BAR; PG8_WAIT_L(0); PG8_MMA(0, 1, At, B1); PG8_BAR;
            PG8_LDA(At, 0, 1); PG8_STAGE(PG8_SA(0, 0), a2, voffA);
            PG8_BAR; PG8_WAIT_L(0); PG8_MMA(1, 0, At, B0); PG8_BAR; PG8_SCHED;
            PG8_STAGE(PG8_SB(0, 1), b2 + hstep, voffB);
            PG8_WAIT_V(6); PG8_BAR; PG8_MMA(1, 1, At, B1); PG8_BAR;
            PG8_LDB(B0, 1, 0); PG8_SCHED; PG8_LDA(At, 1, 0); PG8_STAGE(PG8_SA(0, 1), a2 + hstep, voffA);
            PG8_WAIT_L(8); PG8_BAR; PG8_WAIT_L(0); PG8_MMA(0, 0, At, B0); PG8_BAR; PG8_SCHED;
            PG8_LDB(B1, 1, 1); PG8_STAGE(PG8_SB(1, 0), b3, voffB);
            PG8_BAR; PG8_WAIT_L(0); PG8_MMA(0, 1, At, B1); PG8_BAR;
            PG8_LDA(At, 1, 1); PG8_STAGE(PG8_SA(1, 0), a3, voffA);
            PG8_BAR; PG8_WAIT_L(0); PG8_MMA(1, 0, At, B0); PG8_BAR; PG8_SCHED;
            PG8_STAGE(PG8_SB(1, 1), b3 + hstep, voffB);
            PG8_WAIT_V(6); PG8_BAR; PG8_MMA(1, 1, At, B1); PG8_BAR;
            }
        }
        if constexpr (ALIGN_EPI) { if (wr == 0) PG8_BAR; }
        if constexpr (!Epi::AFTER_DRAIN) { E(acc, cur, wr, wc, fr, fq); S.done(cur); }
        if (!has_next) break;
#pragma unroll
        for (int a = 0; a < 2; ++a)
#pragma unroll
            for (int b = 0; b < 2; ++b)
#pragma unroll
                for (int m = 0; m < 4; ++m)
#pragma unroll
                    for (int n = 0; n < 2; ++n) acc[a][b][m][n] = (f32x4){0.f, 0.f, 0.f, 0.f};
        cur = nxt; cA = nA; cB = nB; ++ui;
        if constexpr (ALIGN_EPI) { if (wr == 1) PG8_BAR; }
    }
    PG8_WAIT_V(0);
    if constexpr (!ALIGN_EPI) { if (wr == 0) PG8_BAR; }
    PG8_BAR;
    if constexpr (Epi::AFTER_DRAIN) { E.fused(acc, cur, wr, wc, fr, fq, lds, wid, lane); S.done(cur); }
#undef PG8_SA
#undef PG8_SB
#undef PG8_STAGE
#undef PG8_LDA
#undef PG8_LDB
#undef PG8_MMA
#undef PG8_WAIT_V
#undef PG8_WAIT_L
#undef PG8_BAR
#undef PG8_SCHED
}
}

#define GAS __attribute__((address_space(1)))
#define LAS __attribute__((address_space(3)))
typedef unsigned short bf16;
typedef unsigned v4u __attribute__((ext_vector_type(4)));
typedef unsigned v2u __attribute__((ext_vector_type(2)));
typedef float f32x4 __attribute__((ext_vector_type(4)));
typedef short bf16x8 __attribute__((ext_vector_type(8)));

constexpr int D = 1024, MX = 32768, MC = 2048, MT = 34816;
constexpr int INC = 2576, DFF = 2816;
constexpr size_t MiB = 1u << 20;
constexpr size_t WS_WIN = 1 * MiB, WS_WOUT = 6 * MiB + MiB / 2, WS_WUP = 9 * MiB, WS_WDOWN = 20 * MiB + MiB / 2, WS_WP = 26 * MiB + MiB / 2;
constexpr size_t WS_MOD = 27 * MiB, WS_GATES = 28 * MiB;
constexpr size_t WS_XN = 32 * MiB;
constexpr size_t WS_QN = 32 * MiB, WS_KT = 66 * MiB;
constexpr size_t WS_P = 100 * MiB;
constexpr size_t P_SPLIT = (size_t)MT * 512;
constexpr size_t WS_OF = 100 * MiB, WS_OB = 134 * MiB;
constexpr size_t WS_WC = 270 * MiB, WS_UT = 338 * MiB, WS_AT = 406 * MiB, WS_YIN = 440 * MiB;
constexpr size_t WS_YX = 270 * MiB;
constexpr size_t WS_G = 96 * MiB, WS_U = 272 * MiB;
constexpr size_t WS_X1 = 448 * MiB;
constexpr size_t WS_Y2 = 32 * MiB;
constexpr size_t WS_EG = 504 * MiB, WS_SD = 506 * MiB, WS_EGL = 508 * MiB;
constexpr int LDS_CTL = 147456;
constexpr int LDS_CW = LDS_CTL + 1024;
constexpr int LDS_BYTES = LDS_CW + 7680;

struct Args { const float* in[21]; float* out; unsigned char* ws; int ph_lo, ph_hi; };

__device__ __forceinline__ unsigned f2bf(float f) { unsigned u = __builtin_bit_cast(unsigned, f); return (u + 0x7fffu + ((u >> 16) & 1u)) >> 16; }
typedef float f32x2_t __attribute__((ext_vector_type(2)));
typedef __bf16 bf16x2_t __attribute__((ext_vector_type(2)));
__device__ __forceinline__ unsigned pk2(float lo, float hi) { const f32x2_t v = {lo, hi}; return __builtin_bit_cast(unsigned, __builtin_convertvector(v, bf16x2_t)); }
__device__ __forceinline__ float bflo(unsigned u) { return __builtin_bit_cast(float, u << 16); }
__device__ __forceinline__ float bfhi(unsigned u) { return __builtin_bit_cast(float, u & 0xffff0000u); }
__device__ __forceinline__ float bf2f(bf16 h) { return __builtin_bit_cast(float, (unsigned)h << 16); }
#define dpp_f(v, ctrl) __builtin_bit_cast(float, __builtin_amdgcn_update_dpp(0, __builtin_bit_cast(int, (v)), (ctrl), 0xf, 0xf, false))
__device__ __forceinline__ float sum16(float v) {
    v += dpp_f(v, 0xB1);
    v += dpp_f(v, 0x4E);
    v += dpp_f(v, 0x141);
    v += dpp_f(v, 0x140);
    return v;
}
__device__ __forceinline__ float wave_sum(float v) {
    v = sum16(v);
    v += __shfl_xor(v, 16); v += __shfl_xor(v, 32);
    return v;
}
__device__ __forceinline__ float silu_f(float v) { return v * __builtin_amdgcn_rcpf(1.f + __expf(-v)); }
__device__ __forceinline__ float rsq_f(float v) { return __builtin_amdgcn_rsqf(v); }
#define LDS_WAIT() asm volatile("s_waitcnt lgkmcnt(0)" ::: "memory")
#define LBAR() __syncthreads()
#define LBAR2() do { asm volatile("s_waitcnt lgkmcnt(0)" ::: "memory"); __builtin_amdgcn_s_barrier(); asm volatile("" ::: "memory"); } while (0)

__device__ __forceinline__ void tr_item(const float* W, int ldw, int c0, int K, bf16* WT, int r0, LAS float* scr, int kb, int nb, int lane) {
    const int k0 = 64 * kb, n0 = 32 * nb;
    float tv[32];
    const float* Wp_ = W + (size_t)(k0 + (lane >> 5)) * ldw + c0 + n0 + (lane & 31);
#pragma unroll
    for (int i = 0; i < 32; ++i) tv[i] = __builtin_nontemporal_load(Wp_ + (size_t)(2 * i) * ldw);
#pragma unroll
    for (int i = 0; i < 32; ++i) scr[(2 * i + (lane >> 5)) * 33 + (lane & 31)] = tv[i];
    LDS_WAIT(); asm volatile("" ::: "memory");
    const int c = lane & 7;
#pragma unroll
    for (int j = 0; j < 4; ++j) { const int n = (lane >> 3) + 8 * j; const LAS float* s = scr + (8 * c) * 33 + n;
        v4u o; o.x = pk2(s[0 * 33], s[1 * 33]); o.y = pk2(s[2 * 33], s[3 * 33]); o.z = pk2(s[4 * 33], s[5 * 33]); o.w = pk2(s[6 * 33], s[7 * 33]);
        *(v4u*)(WT + (size_t)(r0 + n0 + n) * K + k0 + 8 * c) = o; }
    LDS_WAIT(); asm volatile("" ::: "memory");
}

__device__ __forceinline__ void ph_prologue(const Args& a, LAS unsigned char* lds) {
    const int tid = threadIdx.x, lane = tid & 63, wave = tid >> 6;
    unsigned char* ws = a.ws;
    float* MOD = (float*)(ws + WS_MOD);
    for (int j = blockIdx.x; j < 192; j += gridDim.x) {
        LAS float* sc = (LAS float*)lds;
        LAS float* part = (LAS float*)(lds + 9 * 1024 * 4);
        { float cv[18];
#pragma unroll
          for (int i = 0; i < 18; ++i) { const int r = i >> 1, k = ((i & 1) << 9) + tid; cv[i] = r < 8 ? a.in[1][r * 1024 + k] : a.in[3][k]; }
#pragma unroll
          for (int i = 0; i < 18; ++i) sc[tid + 512 * i] = cv[i] / (1.f + expf(-cv[i])); }
        __syncthreads();
        const int kh = lane >> 5, col = lane & 31, n = j * 32 + col;
        float acc[9];
#pragma unroll
        for (int r = 0; r < 9; ++r) acc[r] = 0.f;
        const float* wm = a.in[4] + (size_t)kh * 6144 + n;
        for (int kc = wave * 128; kc < wave * 128 + 128; kc += 64) { float wv[32];
#pragma unroll
            for (int u = 0; u < 32; ++u) wv[u] = __builtin_nontemporal_load(wm + (size_t)(kc + 2 * u) * 6144);
#pragma unroll
            for (int u = 0; u < 32; ++u) {
#pragma unroll
                for (int r = 0; r < 9; ++r) acc[r] += sc[r * 1024 + kc + 2 * u + kh] * wv[u]; } }
#pragma unroll
        for (int r = 0; r < 9; ++r) { acc[r] += __shfl_xor(acc[r], 32); if (kh == 0) part[(wave * 9 + r) * 32 + col] = acc[r]; }
        __syncthreads();
        if (tid < 288) { const int r = tid >> 5, l2 = tid & 31; float s = a.in[5][j * 32 + l2];
#pragma unroll
            for (int w2 = 0; w2 < 8; ++w2) s += part[(w2 * 9 + r) * 32 + l2];
            MOD[r * 6144 + j * 32 + l2] = s; }
        __syncthreads();
    }
    LAS float* scr = (LAS float*)(lds + wave * 16384);
    const int gw = blockIdx.x * 8 + wave, NGW = gridDim.x * 8;
    for (int it = gw; it < 1312; it += NGW) {
        int r = it;
        if (r < 1024) { tr_item(a.in[10], INC, 0, 1024, (bf16*)(ws + WS_WIN), 0, scr, r / 64, r % 64, lane); continue; } r -= 1024;
        if (r < 256) { tr_item(a.in[10], INC, 2064, 1024, (bf16*)(ws + WS_WIN), 2048, scr, r / 16, r % 16, lane); continue; } r -= 256;
        { const int g = r >> 3, q = r & 7; tr_item(a.in[15] + g * 16384, 128, 0, 128, (bf16*)(ws + WS_WP) + g * 16384, 0, scr, q >> 2, q & 3, lane); }
    }
}
__device__ __forceinline__ void late_weights(const Args& a, LAS unsigned char* lds, int gw, int NGW) {
    const int lane = threadIdx.x & 63, wave = threadIdx.x >> 6;
    unsigned char* ws = a.ws;
    LAS float* scr = (LAS float*)(lds + wave * 16384);
    for (int it = gw; it < 4736; it += NGW) {
        int r = it;
        if (r < 512) { tr_item(a.in[17], 1024, 0, 1024, (bf16*)(ws + WS_WOUT), 0, scr, r / 32, r % 32, lane); continue; } r -= 512;
        if (r < 2816) { tr_item(a.in[18], 5632, 0, 1024, (bf16*)(ws + WS_WUP), 0, scr, r / 176, r % 176, lane); continue; } r -= 2816;
        tr_item(a.in[20], 1024, 0, 2816, (bf16*)(ws + WS_WDOWN), 0, scr, r / 32, r % 32, lane);
    }
}

__device__ __forceinline__ void norm1_row(const f32x4 (&A4)[4], const f32x4 (&B4)[4], bf16* XN, bf16* XNC, LAS bf16* hxs, int m, f32x4 (&v)[4], int lane) {
    float s = 0.f;
#pragma unroll
    for (int j = 0; j < 4; ++j) s += (v[j].x * v[j].x + v[j].y * v[j].y) + (v[j].z * v[j].z + v[j].w * v[j].w);
    const float rstd = rsq_f(wave_sum(s) * (1.f / D) + 1e-6f);
    v2u* o8 = (v2u*)(m < MX ? XN + (size_t)m * D : XNC + (size_t)(m - MX) * D) + lane;
#pragma unroll
    for (int j = 0; j < 4; ++j) { v[j] = v[j] * rstd * A4[j] + B4[j];
        v2u o; o.x = pk2(v[j].x, v[j].y); o.y = pk2(v[j].z, v[j].w); o8[64 * j] = o;
        *(LAS v2u*)(hxs + 4 * lane + 256 * j) = o; }
}
__device__ __forceinline__ void norm1_load(const Args& a, int m, f32x4 (&v)[4], int lane) {
    const float* xrow = m < MX ? a.in[0] + (size_t)m * D : a.in[2] + (size_t)(m - MX) * D;
#pragma unroll
    for (int j = 0; j < 4; ++j) v[j] = __builtin_nontemporal_load((const f32x4*)xrow + lane + 64 * j);
}
__device__ __forceinline__ void ph_norm1(const Args& a, LAS unsigned char* lds) {
    const int tid = threadIdx.x, lane = tid & 63, wave = tid >> 6;
    unsigned char* ws = a.ws;
    const float* MOD = (const float*)(ws + WS_MOD);
    float* GATES = (float*)(ws + WS_GATES);
    bf16* XN = (bf16*)(ws + WS_XN); bf16* XNC = (bf16*)(ws + WS_YIN);
    constexpr int WGS = 1032;
    LAS bf16* wgT = (LAS bf16*)lds;
    LAS bf16* hxs = (LAS bf16*)(lds + 16 * WGS * 2) + wave * (4 * WGS);
    { float tv[32]; const float* wsrc = a.in[10] + 2048 + (tid & 15) + (size_t)(tid >> 4) * INC;
#pragma unroll
      for (int i = 0; i < 32; ++i) tv[i] = wsrc[(size_t)(32 * i) * INC];
#pragma unroll
      for (int i = 0; i < 32; ++i) wgT[(tid & 15) * WGS + (tid >> 4) + 32 * i] = (bf16)pk2(tv[i], 0.f); }
    __syncthreads();
    const int r16 = lane & 15, q4 = lane >> 4;
    const int gw = blockIdx.x * 8 + wave, NGW = gridDim.x * 8;
    for (int m0 = gw * 4; m0 < MX; m0 += NGW * 4) {
        f32x4 va[4], vb[4], vc[4], vd[4];
        norm1_load(a, m0, va, lane); norm1_load(a, m0 + 1, vb, lane); norm1_load(a, m0 + 2, vc, lane); norm1_load(a, m0 + 3, vd, lane);
        const int mr = m0 >> 12;
        f32x4 A4[4], B4[4];
#pragma unroll
        for (int j = 0; j < 4; ++j) { const f32x4 g = ((const f32x4*)a.in[6])[lane + 64 * j], sc = ((const f32x4*)(MOD + mr * 6144 + 1024))[lane + 64 * j]; A4[j] = g * (sc + 1.0f); B4[j] = ((const f32x4*)(MOD + mr * 6144))[lane + 64 * j]; }
        norm1_row(A4, B4, XN, XNC, hxs, m0, va, lane);
        norm1_row(A4, B4, XN, XNC, hxs + WGS, m0 + 1, vb, lane);
        norm1_row(A4, B4, XN, XNC, hxs + 2 * WGS, m0 + 2, vc, lane);
        norm1_row(A4, B4, XN, XNC, hxs + 3 * WGS, m0 + 3, vd, lane);
        LDS_WAIT(); asm volatile("" ::: "memory");
        f32x4 acc = (f32x4){0.f, 0.f, 0.f, 0.f};
        const LAS bf16* ap = wgT + r16 * WGS + q4 * 8; const LAS bf16* bp = hxs + (r16 & 3) * WGS + q4 * 8;
#pragma unroll 8
        for (int ks = 0; ks < 32; ++ks) { const bf16x8 av = *(const LAS bf16x8*)(ap + ks * 32); const bf16x8 bv = *(const LAS bf16x8*)(bp + ks * 32); acc = __builtin_amdgcn_mfma_f32_16x16x32_bf16(av, bv, acc, 0, 0, 0); }
        if (r16 < 4) *(f32x4*)(GATES + (size_t)(m0 + r16) * 16 + q4 * 4) = acc;
        LDS_WAIT(); asm volatile("" ::: "memory");
    }
    for (int m = MX + gw; m < MT; m += NGW) {
        f32x4 va[4]; norm1_load(a, m, va, lane);
        f32x4 A4[4], B4[4];
#pragma unroll
        for (int j = 0; j < 4; ++j) { const f32x4 g = ((const f32x4*)a.in[6])[lane + 64 * j], sc = ((const f32x4*)(MOD + 8 * 6144 + 1024))[lane + 64 * j]; A4[j] = g * (sc + 1.0f); B4[j] = ((const f32x4*)(MOD + 8 * 6144))[lane + 64 * j]; }
        norm1_row(A4, B4, XN, XNC, hxs, m, va, lane);
        LDS_WAIT(); asm volatile("" ::: "memory");
        f32x4 acc = (f32x4){0.f, 0.f, 0.f, 0.f};
        const LAS bf16* ap = wgT + r16 * WGS + q4 * 8; const LAS bf16* bp = hxs + q4 * 8;
#pragma unroll 8
        for (int ks = 0; ks < 32; ++ks) { const bf16x8 av = *(const LAS bf16x8*)(ap + ks * 32); const bf16x8 bv = *(const LAS bf16x8*)(bp + ks * 32); acc = __builtin_amdgcn_mfma_f32_16x16x32_bf16(av, bv, acc, 0, 0, 0); }
        if (r16 == 0) *(f32x4*)(GATES + (size_t)m * 16 + q4 * 4) = acc;
        LDS_WAIT(); asm volatile("" ::: "memory");
    }
    __syncthreads();
}

constexpr int SQS = 136;
constexpr int TS = 72;
__device__ __forceinline__ void prep_load(const Args& a, int item, v4u (&ldv)[3][6]) {
    int tl = threadIdx.x; asm volatile("" : "+v"(tl));
    const int cgp = tl & 15, run = tl >> 4, i0 = 2 * run;
    int s, n, h, rowbase, T_;
    if (item < 2048) { h = item & 3; n = (item >> 2) & 63; s = item >> 8; rowbase = s * 4096; T_ = 4096; }
    else { const int r = item - 2048; h = r & 3; n = (r >> 2) & 3; s = r >> 4; rowbase = MX + s * 256; T_ = 256; }
    const bf16* P = (const bf16*)(a.ws + WS_P) + h * 128 + 8 * cgp;
#pragma unroll
    for (int X = 0; X < 3; ++X)
#pragma unroll
        for (int rr = 0; rr < 6; ++rr) { const int t = n * 64 + i0 - 2 + rr; ldv[X][rr] = (v4u){0u, 0u, 0u, 0u};
            if (t >= 0 && t < T_) ldv[X][rr] = __builtin_nontemporal_load((const v4u*)(P + (size_t)X * P_SPLIT + (size_t)(rowbase + t) * 512)); }
}
__device__ __forceinline__ void prep_item(const Args& a, LAS unsigned char* lds, int item, v4u (&ldv)[3][6], int next_item) {
    const int tid = threadIdx.x, lane = tid & 63, wave = tid >> 6;
    unsigned char* ws = a.ws;
    int s, n, h, rowbase, T_;
    const bool isx = item < 2048;
    if (isx) { h = item & 3; n = (item >> 2) & 63; s = item >> 8; rowbase = s * 4096; T_ = 4096; }
    else { const int r = item - 2048; h = r & 3; n = (r >> 2) & 3; s = r >> 4; rowbase = MX + s * 256; T_ = 256; }
    LAS bf16* sQ = (LAS bf16*)lds;
    LAS bf16* sK = (LAS bf16*)(lds + 17408);
    LAS bf16* sKT = (LAS bf16*)(lds + 34816);
    LAS bf16* sVT = (LAS bf16*)(lds + 53248);
    LAS float* Lm = (LAS float*)(lds + 71680);
    LAS float* Tm = (LAS float*)(lds + 108544);
    LAS float* gc = (LAS float*)(lds + 145408);
    LAS float* be = gc + 128;
    LAS float* egc = be + 128;
    const bf16* P = (const bf16*)(ws + WS_P);
    bf16* Qn = (bf16*)(ws + WS_QN) + (size_t)item * 8192;
    bf16* KT = (bf16*)(ws + WS_KT) + (size_t)item * 8192;
    if (gridDim.x & 3) {
        __syncthreads();
        for (int idx = tid; idx < 1920; idx += 512) { const int X = idx / 640, j = (idx / 128) % 5, c = idx & 127; ((LAS float*)(lds + LDS_CW))[idx] = a.in[11][j * 1536 + X * 512 + h * 128 + c]; }
        __syncthreads();
    }
    {
        int tl = tid; asm volatile("" : "+v"(tl));
        const int cgp = tl & 15, run = tl >> 4, i0 = 2 * run;
#pragma unroll
        for (int X = 0; X < 3; ++X) {
            float in[6][8];
#pragma unroll
            for (int rr = 0; rr < 6; ++rr) { const int t = n * 64 + i0 - 2 + rr;
                const v4u u = ldv[X][rr]; (void)t;
                in[rr][0] = bflo(u.x); in[rr][1] = bfhi(u.x); in[rr][2] = bflo(u.y); in[rr][3] = bfhi(u.y); in[rr][4] = bflo(u.z); in[rr][5] = bfhi(u.z); in[rr][6] = bflo(u.w); in[rr][7] = bfhi(u.w); }
            float o0[8], o1[8];
#pragma unroll
            for (int e = 0; e < 8; ++e) { o0[e] = 0.f; o1[e] = 0.f; }
            const LAS float* cw = (const LAS float*)(lds + LDS_CW) + X * 640 + 8 * cgp;
#pragma unroll
            for (int j = 0; j < 5; ++j) { const f32x4 w0 = *(const LAS f32x4*)(cw + j * 128), w1 = *(const LAS f32x4*)(cw + j * 128 + 4);
                const float w[8] = {w0.x, w0.y, w0.z, w0.w, w1.x, w1.y, w1.z, w1.w};
#pragma unroll
                for (int e = 0; e < 8; ++e) { o0[e] += w[e] * in[j][e]; o1[e] += w[e] * in[j + 1][e]; } }
            float s0 = 0.f, s1 = 0.f;
#pragma unroll
            for (int e = 0; e < 8; ++e) { o0[e] = silu_f(o0[e]); o1[e] = silu_f(o1[e]); s0 += o0[e] * o0[e]; s1 += o1[e] * o1[e]; }
            if (X < 2) { s0 = sum16(s0); s1 = sum16(s1);
                float r0 = rsq_f(s0 + 1e-6f), r1 = rsq_f(s1 + 1e-6f);
                if (X == 0) { r0 *= 0.08838834764831845f; r1 *= 0.08838834764831845f; }
#pragma unroll
                for (int e = 0; e < 8; ++e) { o0[e] *= r0; o1[e] *= r1; } }
            if (X < 2) {
                v4u w0, w1; w0.x = pk2(o0[0], o0[1]); w0.y = pk2(o0[2], o0[3]); w0.z = pk2(o0[4], o0[5]); w0.w = pk2(o0[6], o0[7]);
                w1.x = pk2(o1[0], o1[1]); w1.y = pk2(o1[2], o1[3]); w1.z = pk2(o1[4], o1[5]); w1.w = pk2(o1[6], o1[7]);
                LAS bf16* sX = X == 0 ? sQ : sK;
                *(LAS v4u*)(sX + i0 * SQS + 8 * cgp) = w0; *(LAS v4u*)(sX + (i0 + 1) * SQS + 8 * cgp) = w1;
                if (X == 0 && isx) { __builtin_nontemporal_store(w0, (v4u*)(Qn + i0 * 128 + 8 * cgp)); __builtin_nontemporal_store(w1, (v4u*)(Qn + (i0 + 1) * 128 + 8 * cgp)); }
            }
            if (X >= 1) { LAS bf16* sT = X == 1 ? sKT : sVT;
#pragma unroll
                for (int e = 0; e < 8; ++e) { const unsigned pr = pk2(o0[e], o1[e]); *(LAS unsigned*)(sT + (8 * cgp + e) * TS + ((((i0 >> 3) ^ (cgp & 7)) << 3) | (i0 & 7))) = pr; } }
        }
    }
    if (next_item >= 0) prep_load(a, next_item, ldv);
    if (wave < 2) {
        const int d = wave, ip = lane, tok = d ? 63 - ip : ip;
        const float* GATES = (const float*)(ws + WS_GATES) + (size_t)(rowbase + n * 64 + tok) * 16;
        const float ga = GATES[8 + 4 * d + h], gb = GATES[4 * d + h];
        const float A = expf(a.in[12][d * 4 + h]), dtb = a.in[13][d * 4 + h];
        const float xg = ga + dtb;
        const float sp = fmaxf(xg, 0.f) + log1pf(expf(-fabsf(xg)));
        float g = -A * sp;
        const float beta = 1.f / (1.f + expf(-gb));
#pragma unroll
        for (int off = 1; off < 64; off <<= 1) { const float t = __shfl_up(g, off); if (lane >= off) g += t; }
        const float glast = __shfl(g, 63);
        gc[d * 64 + ip] = g; be[d * 64 + ip] = beta; egc[d * 64 + ip] = expf(g);
        const int cidx = item * 2 + d;
        ((float*)(ws + WS_EG))[(size_t)cidx * 64 + ip] = expf(g);
        ((float*)(ws + WS_SD))[(size_t)cidx * 64 + ip] = expf(glast - g);
        if (lane == 63) ((float*)(ws + WS_EGL))[cidx] = expf(g);
    }
    LBAR2();
    {
        int ll = lane; asm volatile("" : "+v"(ll));
        const int r16 = ll & 15, q4 = ll >> 4;
#pragma unroll
        for (int tt = 0; tt < 4; ++tt) {
            const int T = wave * 4 + tt, which = T >> 4, mt = (T >> 2) & 3, nt = T & 3;
            const LAS bf16* sB = sK - which * (64 * SQS);
            f32x4 acc = (f32x4){0.f, 0.f, 0.f, 0.f};
#pragma unroll
            for (int ks = 0; ks < 4; ++ks) { const bf16x8 av = *(const LAS bf16x8*)(sK + (mt * 16 + r16) * SQS + ks * 32 + q4 * 8); const bf16x8 bv = *(const LAS bf16x8*)(sB + (nt * 16 + r16) * SQS + ks * 32 + q4 * 8);
                acc = __builtin_amdgcn_mfma_f32_16x16x32_bf16(av, bv, acc, 0, 0, 0); }
            const int c = nt * 16 + r16, cb = 63 - c, m0 = mt * 16 + q4 * 4;
            if (which == 0) {
#pragma unroll
                for (int j = 0; j < 4; ++j) { const int i = m0 + j, ib = 63 - i; const float v = acc[j];
                    Lm[i * TS + c] = (i > c) ? be[i] * v * __expf(gc[i] - gc[c]) : 0.f;
                    Lm[64 * TS + ib * TS + cb] = (ib > cb) ? be[64 + ib] * v * __expf(gc[64 + ib] - gc[64 + cb]) : 0.f; }
            } else if (isx) {
                float f[4], g[4];
#pragma unroll
                for (int j = 0; j < 4; ++j) { const int jj = m0 + j, jb = 63 - jj; const float v = acc[j];
                    f[j] = (c >= jj) ? v * __expf(gc[c] - gc[jj]) : 0.f;
                    g[j] = (cb >= jb) ? v * __expf(gc[64 + cb] - gc[64 + jb]) : 0.f; }
                LAS bf16* sAT = (LAS bf16*)Tm;
                v2u o; o.x = pk2(f[0], f[1]); o.y = pk2(f[2], f[3]); *(LAS v2u*)(sAT + c * 64 + (((m0 >> 3) ^ (c & 7)) << 3) + (m0 & 4)) = o;
                const int kb = 60 - m0;
                v2u p; p.x = pk2(g[3], g[2]); p.y = pk2(g[1], g[0]); *(LAS v2u*)(sAT + 4096 + cb * 64 + (((kb >> 3) ^ (cb & 7)) << 3) + (kb & 4)) = p;
            }
        }
    }
    LBAR2();
    {
        int tl = tid; asm volatile("" : "+v"(tl));
#pragma unroll
        for (int k = 0; k < 2; ++k) { const int cc = tl + 512 * k, row = cc >> 3, ch = cc & 7;
            { const int ln = cc & 63, krow = (cc >> 7) * 16 + (ln & 15), kch = ((cc >> 6) & 1) * 4 + (ln >> 4);
              __builtin_nontemporal_store(*(const LAS v4u*)(sKT + krow * TS + ((kch ^ ((krow >> 3) & 7)) << 3)), (v4u*)(KT + cc * 8)); }
            if (isx) __builtin_nontemporal_store(*(const LAS v4u*)((const LAS bf16*)Tm + row * 64 + ((ch ^ (row & 7)) << 3)), (v4u*)((bf16*)(ws + WS_AT) + (size_t)(item * 2) * 4096 + cc * 8)); }
    }
    LBAR2();
    if (tid < 128) {
        int tl = tid; asm volatile("" : "+v"(tl));
        const int d = tl >> 6, k = (tl >> 4) & 3, c = tl & 15;
        const LAS float* Lb = Lm + d * (64 * TS) + (16 * k) * TS + 16 * k;
        LAS float* Tb = Tm + d * (64 * TS) + (16 * k) * TS + 16 * k;
        float x[16];
#pragma unroll
        for (int i = 0; i < 16; ++i) x[i] = (i == c) ? 1.f : 0.f;
#pragma unroll
        for (int i = 1; i < 16; ++i) { float acc = 0.f;
#pragma unroll
            for (int j = 0; j < i; ++j) acc += Lb[i * TS + j] * x[j];
            x[i] -= acc; }
#pragma unroll
        for (int i = 0; i < 16; ++i) Tb[i * TS + c] = x[i];
    }
    LBAR2();
    {
        int ll = lane; asm volatile("" : "+v"(ll));
        const int r16 = ll & 15, q4 = ll >> 4;
        const int d = wave >> 2, w = __builtin_amdgcn_readfirstlane(wave & 3);
        const LAS float* Ld = Lm + d * (64 * TS); LAS float* Td = Tm + d * (64 * TS);
        LAS float* tmp = (LAS float*)lds + d * 1920;
#define BLK(P, i, j) ((P) + (16 * (i)) * TS + 16 * (j))
#define TMPB(sl) (tmp + (sl) * 320)
#define MM16(acc, A, lda, B, ldb) do { _Pragma("unroll") for (int ks = 0; ks < 4; ++ks) (acc) = __builtin_amdgcn_mfma_f32_16x16x4f32((A)[r16 * (lda) + 4 * ks + q4], (B)[(4 * ks + q4) * (ldb) + r16], (acc), 0, 0, 0); } while (0)
#define ST16(P, ld, acc, sg) do { _Pragma("unroll") for (int j = 0; j < 4; ++j) (P)[(4 * q4 + j) * (ld) + r16] = (sg) * (acc)[j]; } while (0)
#define LD16(acc, P, ld) do { _Pragma("unroll") for (int j = 0; j < 4; ++j) (acc)[j] = (P)[(4 * q4 + j) * (ld) + r16]; } while (0)
        const f32x4 z4 = (f32x4){0.f, 0.f, 0.f, 0.f};
        f32x4 acc;
        if (w == 0) { acc = z4; MM16(acc, BLK(Ld, 1, 0), TS, BLK(Td, 0, 0), TS); ST16(TMPB(0), 20, acc, 1.f); acc = z4; MM16(acc, BLK(Ld, 3, 0), TS, BLK(Td, 0, 0), TS); ST16(TMPB(2), 20, acc, 1.f); }
        else if (w == 1) { acc = z4; MM16(acc, BLK(Ld, 2, 1), TS, BLK(Td, 1, 1), TS); ST16(TMPB(3), 20, acc, 1.f); acc = z4; MM16(acc, BLK(Ld, 3, 1), TS, BLK(Td, 1, 1), TS); ST16(TMPB(4), 20, acc, 1.f); }
        else if (w == 2) { acc = z4; MM16(acc, BLK(Ld, 3, 2), TS, BLK(Td, 2, 2), TS); ST16(TMPB(5), 20, acc, 1.f); }
        else { acc = z4; MM16(acc, BLK(Ld, 2, 0), TS, BLK(Td, 0, 0), TS); ST16(TMPB(1), 20, acc, 1.f); }
        LBAR2();
        if (w == 0) { acc = z4; MM16(acc, BLK(Td, 1, 1), TS, TMPB(0), 20); ST16(BLK(Td, 1, 0), TS, acc, -1.f); }
        else if (w == 1) { acc = z4; MM16(acc, BLK(Td, 2, 2), TS, TMPB(3), 20); ST16(BLK(Td, 2, 1), TS, acc, -1.f); }
        else if (w == 2) { acc = z4; MM16(acc, BLK(Td, 3, 3), TS, TMPB(5), 20); ST16(BLK(Td, 3, 2), TS, acc, -1.f); }
        LBAR2();
        if (w == 0) { LD16(acc, TMPB(1), 20); MM16(acc, BLK(Ld, 2, 1), TS, BLK(Td, 1, 0), TS); ST16(TMPB(1), 20, acc, 1.f); }
        else if (w == 1) { LD16(acc, TMPB(4), 20); MM16(acc, BLK(Ld, 3, 2), TS, BLK(Td, 2, 1), TS); ST16(TMPB(4), 20, acc, 1.f); }
        else if (w == 2) { LD16(acc, TMPB(2), 20); MM16(acc, BLK(Ld, 3, 1), TS, BLK(Td, 1, 0), TS); ST16(TMPB(2), 20, acc, 1.f); }
        LBAR2();
        if (w == 0) { acc = z4; MM16(acc, BLK(Td, 2, 2), TS, TMPB(1), 20); ST16(BLK(Td, 2, 0), TS, acc, -1.f);
            LDS_WAIT(); asm volatile("" ::: "memory");
            LD16(acc, TMPB(2), 20); MM16(acc, BLK(Ld, 3, 2), TS, BLK(Td, 2, 0), TS); ST16(TMPB(2), 20, acc, 1.f);
            LDS_WAIT(); asm volatile("" ::: "memory");
            acc = z4; MM16(acc, BLK(Td, 3, 3), TS, TMPB(2), 20); ST16(BLK(Td, 3, 0), TS, acc, -1.f); }
        else if (w == 1) { acc = z4; MM16(acc, BLK(Td, 3, 3), TS, TMPB(4), 20); ST16(BLK(Td, 3, 1), TS, acc, -1.f); }
#undef BLK
#undef TMPB
#undef MM16
#undef ST16
#undef LD16
    }
    LBAR2();
    {
        int tl = tid; asm volatile("" : "+v"(tl));
#pragma unroll
        for (int k = 0; k < 2; ++k) { const int gidx = tl + 512 * k, d = gidx >> 9, ip = (gidx >> 3) & 63, j8 = gidx & 7;
            const LAS float* Tr = Tm + d * (64 * TS) + ip * TS + 8 * j8;
            const f32x4 t0 = *(const LAS f32x4*)Tr, t1 = *(const LAS f32x4*)(Tr + 4);
            const f32x4 b0 = *(const LAS f32x4*)(be + d * 64 + 8 * j8), b1 = *(const LAS f32x4*)(be + d * 64 + 8 * j8 + 4);
            const f32x4 e0 = *(const LAS f32x4*)(egc + d * 64 + 8 * j8), e1 = *(const LAS f32x4*)(egc + d * 64 + 8 * j8 + 4);
            const bool up = (8 * j8) > (ip | 15);
            f32x4 u0 = t0 * b0, u1 = t1 * b1; if (up) { u0 = (f32x4){0.f, 0.f, 0.f, 0.f}; u1 = u0; }
            const f32x4 w0 = u0 * e0, w1 = u1 * e1;
            LAS bf16* Tu = (LAS bf16*)(Lm + d * (64 * TS)); LAS bf16* Tw = Tu + 64 * TS;
            v4u ou, ow; int pos;
            if (d) { ou.x = pk2(u1.w, u1.z); ou.y = pk2(u1.y, u1.x); ou.z = pk2(u0.w, u0.z); ou.w = pk2(u0.y, u0.x);
                     ow.x = pk2(w1.w, w1.z); ow.y = pk2(w1.y, w1.x); ow.z = pk2(w0.w, w0.z); ow.w = pk2(w0.y, w0.x); pos = 56 - 8 * j8; }
            else { ou.x = pk2(u0.x, u0.y); ou.y = pk2(u0.z, u0.w); ou.z = pk2(u1.x, u1.y); ou.w = pk2(u1.z, u1.w);
                   ow.x = pk2(w0.x, w0.y); ow.y = pk2(w0.z, w0.w); ow.z = pk2(w1.x, w1.y); ow.w = pk2(w1.z, w1.w); pos = 8 * j8; }
            asm volatile("" ::: "memory");
            *(LAS v4u*)(Tu + ip * TS + pos) = ou; *(LAS v4u*)(Tw + ip * TS + pos) = ow; }
    }
    LBAR2();
    {
        int ll = lane; asm volatile("" : "+v"(ll));
        const int r16 = ll & 15, q4 = ll >> 4;
        const int d = wave >> 2, rt = wave & 3;
        const LAS bf16* Tu = (const LAS bf16*)(Lm + d * (64 * TS)); const LAS bf16* Tw = Tu + 64 * TS;
        LAS bf16* sU = (LAS bf16*)lds + d * 8192;
        LAS bf16* sW = (LAS bf16*)Tm + d * 8192;
        bf16x8 tu[2], tw[2];
#pragma unroll
        for (int ks = 0; ks < 2; ++ks) { tu[ks] = *(const LAS bf16x8*)(Tu + (rt * 16 + r16) * TS + ks * 32 + q4 * 8); tw[ks] = *(const LAS bf16x8*)(Tw + (rt * 16 + r16) * TS + ks * 32 + q4 * 8); }
#pragma unroll
        for (int ct = 0; ct < 8; ++ct) {
            f32x4 au = (f32x4){0.f, 0.f, 0.f, 0.f}, aw = au;
#pragma unroll
            for (int ks = 0; ks < 2; ++ks) { const int swz_ = (((ks * 4 + q4) ^ ((2 * ct + (r16 >> 3)) & 7)) << 3); const bf16x8 vv = *(const LAS bf16x8*)(sVT + (ct * 16 + r16) * TS + swz_); const bf16x8 kv = *(const LAS bf16x8*)(sKT + (ct * 16 + r16) * TS + swz_);
                au = __builtin_amdgcn_mfma_f32_16x16x32_bf16(tu[ks], vv, au, 0, 0, 0);
                aw = __builtin_amdgcn_mfma_f32_16x16x32_bf16(kv, tw[ks], aw, 0, 0, 0); }
            { const int row = ct * 16 + r16, p0 = rt * 16 + q4 * 4;
              v2u o; o.x = pk2(au[0], au[1]); o.y = pk2(au[2], au[3]); *(LAS v2u*)(sU + row * 64 + (((p0 >> 3) ^ (row & 7)) << 3) + (p0 & 4)) = o; }
            { const int row = rt * 16 + r16, p0 = ct * 16 + q4 * 4;
              v2u p; p.x = pk2(aw[0], aw[1]); p.y = pk2(aw[2], aw[3]); *(LAS v2u*)(sW + row * 128 + (((p0 >> 3) ^ (row & 15)) << 3) + (p0 & 4)) = p; }
        }
    }
    LBAR2();
    {
        int tl = tid; asm volatile("" : "+v"(tl));
        bf16* Ut = (bf16*)(ws + WS_UT) + (size_t)(item * 2) * 8192; bf16* Wc = (bf16*)(ws + WS_WC) + (size_t)(item * 2) * 8192;
#pragma unroll
        for (int k = 0; k < 4; ++k) { const int cc = tl + 512 * k;
            { const int row = (cc >> 3) & 127, ch = cc & 7, dd = cc >> 10; const LAS bf16* sUd = (const LAS bf16*)lds + dd * 8192; const int u0 = (cc & 1023) * 2;
              v4u o; { const int un = u0, ln = un & 63, rw = ((un >> 6) & 7) * 16 + (ln & 15), ip = (un >> 9) * 16 + (ln >> 4) * 4; const v2u t = *(const LAS v2u*)(sUd + rw * 64 + (((ip >> 3) ^ (rw & 7)) << 3) + (ip & 4)); o.x = t.x; o.y = t.y; }
              { const int un = u0 + 1, ln = un & 63, rw = ((un >> 6) & 7) * 16 + (ln & 15), ip = (un >> 9) * 16 + (ln >> 4) * 4; const v2u t = *(const LAS v2u*)(sUd + rw * 64 + (((ip >> 3) ^ (rw & 7)) << 3) + (ip & 4)); o.z = t.x; o.w = t.y; }
              __builtin_nontemporal_store(o, (v4u*)(Ut + cc * 8)); }
            { const int f = cc & 1023, ln = f & 63, row = (f >> 8) * 16 + (ln & 15), ch = ((f >> 6) & 3) * 4 + (ln >> 4), dd = cc >> 10;
              __builtin_nontemporal_store(*(const LAS v4u*)((const LAS bf16*)Tm + dd * 8192 + row * 128 + ((ch ^ (row & 15)) << 3)), (v4u*)(Wc + cc * 8)); } }
    }
    LBAR2();
}

__device__ __forceinline__ void pool_item(const Args& a, LAS unsigned char* lds, int it) {
    const int tid = threadIdx.x, lane = tid & 63, wave = tid >> 6;
    unsigned char* ws = a.ws;
    const int r = it & 63, g = (it >> 6) & 3, b = it >> 8;
    const int w = 2 << g, left = w >> 1, right = w - 1 - left;
    const bf16* PP = (const bf16*)(ws + WS_P) + 4 * P_SPLIT + (size_t)b * 4096 * 512 + g * 128;
    LAS float* V = (LAS float*)lds;
    LAS bf16* sD = (LAS bf16*)(lds + 64 * 132 * 4);
    const int rlo = max(0, r - left), rhi = min(63, r + right);
    const float inv_r = 1.f / (float)(rhi - rlo + 1);
    float u[2][8];
#pragma unroll
    for (int k = 0; k < 2; ++k) { const int pr = tid + 512 * k, c = pr >> 4, cgp = pr & 15;
        float acc[8];
#pragma unroll
        for (int e = 0; e < 8; ++e) acc[e] = 0.f;
        v4u qv[16];
#pragma unroll
        for (int rr = 0; rr < 16; ++rr) { const int rp = rlo + rr; qv[rr] = (v4u){0u, 0u, 0u, 0u}; if (rp <= rhi) qv[rr] = *(const v4u*)(PP + (size_t)(rp * 64 + c) * 512 + 8 * cgp); }
#pragma unroll
        for (int rr = 0; rr < 16; ++rr) { const v4u q = qv[rr];
            const float f[8] = {bflo(q.x), bfhi(q.x), bflo(q.y), bfhi(q.y), bflo(q.z), bfhi(q.z), bflo(q.w), bfhi(q.w)};
#pragma unroll
            for (int e = 0; e < 8; ++e) acc[e] += f[e];
            if (rlo + rr == r) {
#pragma unroll
                for (int e = 0; e < 8; ++e) u[k][e] = f[e]; } }
        *(LAS f32x4*)(V + c * 132 + 8 * cgp) = (f32x4){acc[0] * inv_r, acc[1] * inv_r, acc[2] * inv_r, acc[3] * inv_r};
        *(LAS f32x4*)(V + c * 132 + 8 * cgp + 4) = (f32x4){acc[4] * inv_r, acc[5] * inv_r, acc[6] * inv_r, acc[7] * inv_r}; }
    LBAR();
#pragma unroll
    for (int k = 0; k < 2; ++k) { const int pr = tid + 512 * k, c = pr >> 4, cgp = pr & 15;
        const int clo = max(0, c - left), chi = min(63, c + right); const float inv_c = 1.f / (float)(chi - clo + 1);
        f32x4 m0 = (f32x4){0.f, 0.f, 0.f, 0.f}, m1 = m0;
        for (int cp = clo; cp <= chi; ++cp) { m0 += *(const LAS f32x4*)(V + cp * 132 + 8 * cgp); m1 += *(const LAS f32x4*)(V + cp * 132 + 8 * cgp + 4); }
        v4u o; o.x = pk2(m0.x * inv_c - u[k][0], m0.y * inv_c - u[k][1]); o.y = pk2(m0.z * inv_c - u[k][2], m0.w * inv_c - u[k][3]);
        o.z = pk2(m1.x * inv_c - u[k][4], m1.y * inv_c - u[k][5]); o.w = pk2(m1.z * inv_c - u[k][6], m1.w * inv_c - u[k][7]);
        *(LAS v4u*)(sD + c * 136 + 8 * cgp) = o; }
    LBAR();
    {
        const int r16 = lane & 15, q4 = lane >> 4, nt = wave;
        const bf16* Wp = (const bf16*)(ws + WS_WP) + g * 16384;
        bf16x8 bfr[4];
#pragma unroll
        for (int ks = 0; ks < 4; ++ks) bfr[ks] = *(const bf16x8*)(Wp + (nt * 16 + r16) * 128 + ks * 32 + q4 * 8);
        const float psc = a.in[16][g * 128 + nt * 16 + r16];
        LAS bf16* sY = (LAS bf16*)V;
#pragma unroll
        for (int mt = 0; mt < 4; ++mt) { f32x4 acc = (f32x4){0.f, 0.f, 0.f, 0.f};
#pragma unroll
            for (int ks = 0; ks < 4; ++ks) { const bf16x8 av = *(const LAS bf16x8*)(sD + (mt * 16 + r16) * 136 + ks * 32 + q4 * 8); acc = __builtin_amdgcn_mfma_f32_16x16x32_bf16(av, bfr[ks], acc, 0, 0, 0); }
#pragma unroll
            for (int j = 0; j < 4; ++j) sY[(mt * 16 + q4 * 4 + j) * 136 + nt * 16 + r16] = (bf16)pk2(acc[j] * psc, 0.f); }
    }
    LBAR();
    {
        bf16* YIN = (bf16*)(ws + WS_YIN) + (size_t)(b * 4096 + r * 64) * 1024 + 512 + g * 128;
#pragma unroll
        for (int k = 0; k < 2; ++k) { const int cc = tid + 512 * k; *(v4u*)(YIN + (size_t)(cc >> 4) * 1024 + (cc & 15) * 8) = *(const LAS v4u*)((const LAS bf16*)V + (cc >> 4) * 136 + (cc & 15) * 8); }
    }
    LBAR();
}

struct ScanFrag { bf16x8 aW[4], aK[2]; v2u u[2]; f32x4 sd; float egl; };
__device__ __forceinline__ int scan_cidx(int step, int b, int h, int d) {
    int item;
    if (step < 4) { const int n = d ? 3 - step : step; item = 2048 + (b * 4 + n) * 4 + h; }
    else { const int np = step - 4; const int n = d ? 63 - np : np; item = (b * 64 + n) * 4 + h; }
    return item * 2 + d;
}
__device__ __forceinline__ void scan_load(ScanFrag& f, const unsigned char* ws, int step, int b, int h, int d, int sl, int wave, int r16, int q4) {
    step = step < 68 ? step : 67;
    const int mt = wave >> 1, nh = wave & 1;
    const int cidx = scan_cidx(step, b, h, d), item = cidx >> 1;
    const bf16* Wc = (const bf16*)(ws + WS_WC) + (size_t)cidx * 8192;
    const bf16* Ut = (const bf16*)(ws + WS_UT) + (size_t)cidx * 8192;
    const bf16* KT = (const bf16*)(ws + WS_KT) + (size_t)item * 8192;
#pragma unroll
    for (int ks = 0; ks < 4; ++ks) f.aW[ks] = *(const bf16x8*)(Wc + (((mt * 4 + ks) * 64 + q4 * 16 + r16) << 3));
#pragma unroll
    for (int ks = 0; ks < 2; ++ks) f.aK[ks] = *(const bf16x8*)(KT + (((wave * 2 + ks) * 64 + q4 * 16 + r16) << 3));
#pragma unroll
    for (int t = 0; t < 2; ++t) f.u[t] = __builtin_nontemporal_load((const v2u*)(Ut + (((mt * 8 + sl * 4 + 2 * nh + t) * 64 + q4 * 16 + r16) << 2)));
    f.sd = *(const f32x4*)((const float*)(ws + WS_SD) + (size_t)cidx * 64 + mt * 16 + q4 * 4);
    f.egl = ((const float*)(ws + WS_EGL))[cidx];
}
template <bool IS_X>
__device__ __forceinline__ void scan_step(const ScanFrag& f, f32x4 (&accS)[4], unsigned char* ws, float* sn_base, int step, int b, int h, int d, int sl, int wave, int r16, int q4, LAS bf16* St, LAS bf16* Vt2) {
    LAS bf16* Vt = Vt2 + 64 * 72;
    const int mt = wave >> 1, nh = wave & 1, ip = mt * 16 + q4 * 4;
    const int cidx = scan_cidx(step, b, h, d);
#pragma unroll
    for (int t = 0; t < 2; ++t) {
        const int ncol = (2 * nh + t) * 16 + r16;
        f32x4 acc1 = (f32x4){0.f, 0.f, 0.f, 0.f};
#pragma unroll
        for (int ks = 0; ks < 4; ++ks) { const bf16x8 sb = *(const LAS bf16x8*)(St + ncol * 136 + ks * 32 + q4 * 8); acc1 = __builtin_amdgcn_mfma_f32_16x16x32_bf16(f.aW[ks], sb, acc1, 0, 0, 0); }
        const float v0 = bflo(f.u[t].x) - acc1[0], v1 = bfhi(f.u[t].x) - acc1[1], v2 = bflo(f.u[t].y) - acc1[2], v3 = bfhi(f.u[t].y) - acc1[3];
        if (IS_X) { v2u o; o.x = pk2(v0, v1); o.y = pk2(v2, v3); *(LAS v2u*)(Vt + ncol * 72 + ip) = o; }
        const float s0 = v0 * f.sd.x, s1 = v1 * f.sd.y, s2 = v2 * f.sd.z, s3 = v3 * f.sd.w;
        v2u o2;
        if (d) { o2.x = pk2(s3, s2); o2.y = pk2(s1, s0); *(LAS v2u*)(Vt2 + ncol * 72 + 60 - ip) = o2; }
        else { o2.x = pk2(s0, s1); o2.y = pk2(s2, s3); *(LAS v2u*)(Vt2 + ncol * 72 + ip) = o2; }
    }
    if (IS_X) { bf16* SN = (bf16*)sn_base + (size_t)cidx * 16384 + (size_t)sl * 8192;
        const int tid_ = wave * 64 + q4 * 16 + r16;
#pragma unroll
        for (int k = 0; k < 2; ++k) { const int c = tid_ + 512 * k, ln = c & 63, row = (c >> 8) * 16 + (ln & 15), ch = ((c >> 6) & 3) * 4 + (ln >> 4);
            __builtin_nontemporal_store(*(const LAS v4u*)(St + row * 136 + ch * 8), (v4u*)(SN + c * 8)); } }
    LBAR2();
    if (IS_X) { const int tid_ = wave * 64 + q4 * 16 + r16;
        const int ln = tid_ & 63, row = (tid_ >> 7) * 16 + (ln & 15), ch = ((tid_ >> 6) & 1) * 4 + (ln >> 4);
        __builtin_nontemporal_store(*(const LAS v4u*)(Vt + row * 72 + ch * 8), (v4u*)((bf16*)(ws + WS_OF) + (size_t)cidx * 8192 + (size_t)sl * 4096 + tid_ * 8)); }
#pragma unroll
    for (int n2 = 0; n2 < 4; ++n2) { accS[n2] = accS[n2] * f.egl;
#pragma unroll
        for (int ks = 0; ks < 2; ++ks) { const bf16x8 vb = *(const LAS bf16x8*)(Vt2 + (n2 * 16 + r16) * 72 + ks * 32 + q4 * 8); accS[n2] = __builtin_amdgcn_mfma_f32_16x16x32_bf16(f.aK[ks], vb, accS[n2], 0, 0, 0); }
        v2u o; o.x = pk2(accS[n2][0], accS[n2][1]); o.y = pk2(accS[n2][2], accS[n2][3]);
        *(LAS v2u*)(St + (n2 * 16 + r16) * 136 + wave * 16 + q4 * 4) = o; }
    LBAR2();
}

template <int MODE>
__device__ __forceinline__ void ph_scan(const Args& a, LAS unsigned char* lds, int nblk) {
    const int tid = threadIdx.x, lane = tid & 63, wave = tid >> 6, r16 = lane & 15, q4 = lane >> 4;
    unsigned char* ws = a.ws;
    LAS bf16* St = (LAS bf16*)lds;
    LAS bf16* Vt2 = St + 64 * 136;
    for (int wi = blockIdx.x; wi < 128; wi += nblk) {
        const int xcd = wi & 7, jq = wi >> 3; const int stream = xcd * 8 + (jq >> 1), sl = jq & 1;
        const int b = stream >> 3, h = (stream >> 1) & 3, d = stream & 1;
        for (int i = tid; i < 64 * 136 / 2; i += 512) ((LAS unsigned*)St)[i] = 0u;
        f32x4 accS[4];
#pragma unroll
        for (int n2 = 0; n2 < 4; ++n2) accS[n2] = (f32x4){0.f, 0.f, 0.f, 0.f};
        ScanFrag f0, f1, f2, f3;
        scan_load(f0, ws, 0, b, h, d, sl, wave, r16, q4);
        scan_load(f1, ws, 1, b, h, d, sl, wave, r16, q4);
        scan_load(f2, ws, 2, b, h, d, sl, wave, r16, q4);
        __syncthreads();
        {
            scan_load(f3, ws, 3, b, h, d, sl, wave, r16, q4); scan_step<false>(f0, accS, ws, a.out, 0, b, h, d, sl, wave, r16, q4, St, Vt2);
            scan_load(f0, ws, 4, b, h, d, sl, wave, r16, q4); scan_step<false>(f1, accS, ws, a.out, 1, b, h, d, sl, wave, r16, q4, St, Vt2);
            scan_load(f1, ws, 5, b, h, d, sl, wave, r16, q4); scan_step<false>(f2, accS, ws, a.out, 2, b, h, d, sl, wave, r16, q4, St, Vt2);
            scan_load(f2, ws, 6, b, h, d, sl, wave, r16, q4); scan_step<false>(f3, accS, ws, a.out, 3, b, h, d, sl, wave, r16, q4, St, Vt2);
        }
        for (int s4 = 4; s4 < 68; s4 += 4) {
            if (MODE != 2) scan_load(f3, ws, s4 + 3, b, h, d, sl, wave, r16, q4); scan_step<MODE == 0>(f0, accS, ws, a.out, s4, b, h, d, sl, wave, r16, q4, St, Vt2);
            if (MODE != 2) scan_load(f0, ws, s4 + 4, b, h, d, sl, wave, r16, q4); scan_step<MODE == 0>(f1, accS, ws, a.out, s4 + 1, b, h, d, sl, wave, r16, q4, St, Vt2);
            if (MODE != 2) scan_load(f1, ws, s4 + 5, b, h, d, sl, wave, r16, q4); scan_step<MODE == 0>(f2, accS, ws, a.out, s4 + 2, b, h, d, sl, wave, r16, q4, St, Vt2);
            if (MODE != 2) scan_load(f2, ws, s4 + 6, b, h, d, sl, wave, r16, q4); scan_step<MODE == 0>(f3, accS, ws, a.out, s4 + 3, b, h, d, sl, wave, r16, q4, St, Vt2);
        }
        asm volatile("s_waitcnt vmcnt(0)" ::: "memory");
        __syncthreads();
    }
}

constexpr int OUT_GRP = 73728;
__device__ __forceinline__ void out_pair(const Args& a, LAS unsigned char* lds0, int pair) {
    const int tid = threadIdx.x, lane = tid & 63, wave = tid >> 6, r16 = lane & 15, q4 = lane >> 4;
    const int grp = wave >> 2, wq = wave & 3, gt = tid & 255;
    unsigned char* ws = a.ws;
    const int item = pair * 2 + grp;
    const int h = item & 3, n = (item >> 2) & 63, b = item >> 8;
    LAS unsigned char* lds = lds0 + grp * OUT_GRP;
    LAS bf16* sQ = (LAS bf16*)lds;
    LAS bf16* sA = (LAS bf16*)(lds + 17408);
    LAS bf16* sZ = (LAS bf16*)(lds + 35840);
    LAS float* red = (LAS float*)(lds + 53248);
    LAS float* rinv = red + 256;
    LAS float* sEG = rinv + 64;
    const size_t trow = (size_t)b * 4096 + n * 64;
    v4u stq[4], sta[4], stz[4];
    {
        const bf16* Qn = (const bf16*)(ws + WS_QN) + (size_t)item * 8192;
        const bf16* AT = (const bf16*)(ws + WS_AT) + (size_t)(item * 2) * 4096;
        const bf16* PZ = (const bf16*)(ws + WS_P) + 3 * P_SPLIT + trow * 512 + h * 128;
#pragma unroll
        for (int k = 0; k < 4; ++k) { const int c = gt + 256 * k; stq[k] = __builtin_nontemporal_load((const v4u*)(Qn + c * 8)); sta[k] = __builtin_nontemporal_load((const v4u*)(AT + c * 8)); stz[k] = __builtin_nontemporal_load((const v4u*)(PZ + (size_t)(c >> 4) * 512 + (c & 15) * 8)); }
    }
    bf16x8 sb[2][2][4], vb[2][2][2];
#define OUT_LOAD_FRAGS(d) do { _Pragma("unroll") for (int t = 0; t < 2; ++t) { \
            const int cidx = item * 2 + (d), nt = 2 * wq + t; \
            const bf16* SN = (const bf16*)a.out + (size_t)cidx * 16384 + (((nt * 4) * 64 + q4 * 16 + r16) << 3); \
            const bf16* VN = (const bf16*)(ws + WS_OF) + (size_t)cidx * 8192 + (((nt * 2) * 64 + q4 * 16 + r16) << 3); \
            _Pragma("unroll") for (int ks = 0; ks < 4; ++ks) sb[d][t][ks] = __builtin_nontemporal_load((const bf16x8*)(SN + ks * 512)); \
            _Pragma("unroll") for (int ks = 0; ks < 2; ++ks) vb[d][t][ks] = __builtin_nontemporal_load((const bf16x8*)(VN + ks * 512)); } } while (0)
    OUT_LOAD_FRAGS(0);
    float egv = 0.f;
    if (gt < 128) egv = ((const float*)(ws + WS_EG))[(size_t)(item * 2) * 64 + gt];
    {
#pragma unroll
        for (int k = 0; k < 4; ++k) { const int c = gt + 256 * k;
            *(LAS v4u*)(sQ + (c >> 4) * 136 + (c & 15) * 8) = stq[k];
            *(LAS v4u*)(sA + (c >> 3) * 72 + (c & 7) * 8) = sta[k];
            *(LAS v4u*)(sZ + (c >> 4) * 136 + (c & 15) * 8) = stz[k]; }
        if (gt < 128) sEG[gt] = egv;
    }
    asm volatile("" ::: "memory");
    OUT_LOAD_FRAGS(1);
#undef OUT_LOAD_FRAGS
    __syncthreads();
    f32x4 o[2][4];
#pragma unroll
    for (int t = 0; t < 2; ++t)
#pragma unroll
        for (int mt = 0; mt < 4; ++mt) o[t][mt] = (f32x4){0.f, 0.f, 0.f, 0.f};
#pragma unroll
    for (int d = 0; d < 2; ++d) {
#pragma unroll
        for (int mt = 0; mt < 4; ++mt) {
            bf16x8 qa[4], aa[2];
#pragma unroll
            for (int ks = 0; ks < 4; ++ks) qa[ks] = *(const LAS bf16x8*)(sQ + (mt * 16 + r16) * 136 + ks * 32 + q4 * 8);
            const int arow = d ? 63 - (mt * 16 + r16) : (mt * 16 + r16);
#pragma unroll
            for (int ks = 0; ks < 2; ++ks) aa[ks] = *(const LAS bf16x8*)(sA + (d * 64 + arow) * 72 + ks * 32 + q4 * 8);
            const int t0 = mt * 16 + q4 * 4;
            f32x4 eg;
            if (d) { const f32x4 e = *(const LAS f32x4*)(sEG + 64 + 60 - t0); eg = (f32x4){e.w, e.z, e.y, e.x}; } else eg = *(const LAS f32x4*)(sEG + t0);
#pragma unroll
            for (int t = 0; t < 2; ++t) {
                f32x4 aq = (f32x4){0.f, 0.f, 0.f, 0.f};
#pragma unroll
                for (int ks = 0; ks < 4; ++ks) aq = __builtin_amdgcn_mfma_f32_16x16x32_bf16(qa[ks], sb[d][t][ks], aq, 0, 0, 0);
                f32x4 acc = aq * eg;
#pragma unroll
                for (int ks = 0; ks < 2; ++ks) acc = __builtin_amdgcn_mfma_f32_16x16x32_bf16(aa[ks], vb[d][t][ks], acc, 0, 0, 0);
                o[t][mt] += acc;
            }
            asm volatile("" ::: "memory");
        }
    }
#pragma unroll
    for (int mt = 0; mt < 4; ++mt)
#pragma unroll
        for (int j = 0; j < 4; ++j) { float p = o[0][mt][j] * o[0][mt][j] + o[1][mt][j] * o[1][mt][j]; p = sum16(p); if (r16 == 0) red[wq * 64 + mt * 16 + q4 * 4 + j] = p; }
    __syncthreads();
    if (gt < 64) { const float t = (red[gt] + red[64 + gt]) + (red[128 + gt] + red[192 + gt]); rinv[gt] = rsq_f(t * (1.f / 128.f) + 1e-6f); }
    __syncthreads();
#pragma unroll
    for (int t = 0; t < 2; ++t) {
        const int v = (2 * wq + t) * 16 + r16; const float onw = a.in[14][v];
#pragma unroll
        for (int mt = 0; mt < 4; ++mt)
#pragma unroll
            for (int j = 0; j < 4; ++j) { const int tk = mt * 16 + q4 * 4 + j; const float z = bf2f(sZ[tk * 136 + v]);
                sQ[tk * 136 + v] = (bf16)pk2(o[t][mt][j] * rinv[tk] * onw * silu_f(z), 0.f); }
    }
    __syncthreads();
    {
        bf16* YIN = (bf16*)(ws + WS_YIN) + trow * 1024 + h * 128;
#pragma unroll
        for (int k = 0; k < 4; ++k) { const int c = gt + 256 * k; *(v4u*)(YIN + (size_t)(c >> 4) * 1024 + (c & 15) * 8) = *(const LAS v4u*)(sQ + (c >> 4) * 136 + (c & 15) * 8); }
    }
    __syncthreads();
}

__device__ __forceinline__ void ph_mid(const Args& a) {
    const int tid = threadIdx.x, lane = tid & 63, wave = tid >> 6;
    unsigned char* ws = a.ws;
    const float* MOD = (const float*)(ws + WS_MOD);
    const bf16* YX = (const bf16*)(ws + WS_YX);
    bf16* XN2 = (bf16*)(ws + WS_XN);
    const int gw = blockIdx.x * 8 + wave, NGW = gridDim.x * 8;
    constexpr int R = 2;
    for (int t0 = gw * R; t0 < MX; t0 += NGW * R) {
        const int b = t0 >> 12;
        f32x4 xv[R][4]; v2u yv[R][4];
#pragma unroll
        for (int r = 0; r < R; ++r)
#pragma unroll
            for (int j = 0; j < 4; ++j) { xv[r][j] = __builtin_nontemporal_load((const f32x4*)(a.in[0] + (size_t)(t0 + r) * D) + lane + 64 * j); yv[r][j] = __builtin_nontemporal_load((const v2u*)(YX + (size_t)(t0 + r) * D) + lane + 64 * j); }
        f32x4 G1[4], GT[4], A2[4], B2[4];
#pragma unroll
        for (int j = 0; j < 4; ++j) { G1[j] = ((const f32x4*)a.in[7])[lane + 64 * j]; GT[j] = ((const f32x4*)(MOD + b * 6144 + 2048))[lane + 64 * j];
            const f32x4 g = ((const f32x4*)a.in[8])[lane + 64 * j], sc = ((const f32x4*)(MOD + b * 6144 + 4096))[lane + 64 * j]; A2[j] = g * (sc + 1.0f); B2[j] = ((const f32x4*)(MOD + b * 6144 + 3072))[lane + 64 * j]; }
#pragma unroll
        for (int r = 0; r < R; ++r) {
            const int t = t0 + r;
            f32x4 y[4]; float s = 0.f;
#pragma unroll
            for (int j = 0; j < 4; ++j) { const v2u q = yv[r][j]; y[j] = (f32x4){bflo(q.x), bfhi(q.x), bflo(q.y), bfhi(q.y)}; s += (y[j].x * y[j].x + y[j].y * y[j].y) + (y[j].z * y[j].z + y[j].w * y[j].w); }
            const float r1 = rsq_f(wave_sum(s) * (1.f / D) + 1e-6f);
            f32x4 x1[4]; float s2 = 0.f;
            v2u* orow = (v2u*)((bf16*)(ws + WS_X1) + (size_t)t * D) + lane;
#pragma unroll
            for (int j = 0; j < 4; ++j) { x1[j] = xv[r][j] + GT[j] * (y[j] * r1 * G1[j]); { v2u ob; ob.x = pk2(x1[j].x, x1[j].y); ob.y = pk2(x1[j].z, x1[j].w); __builtin_nontemporal_store(ob, orow + 64 * j); }
                s2 += (x1[j].x * x1[j].x + x1[j].y * x1[j].y) + (x1[j].z * x1[j].z + x1[j].w * x1[j].w); }
            const float r2 = rsq_f(wave_sum(s2) * (1.f / D) + 1e-6f);
            v2u* o8 = (v2u*)(XN2 + (size_t)t * D) + lane;
#pragma unroll
            for (int j = 0; j < 4; ++j) { const f32x4 hv = x1[j] * r2 * A2[j] + B2[j]; v2u o; o.x = pk2(hv.x, hv.y); o.y = pk2(hv.z, hv.w); o8[64 * j] = o; }
        }
    }
}

template <int NCG>
__device__ __forceinline__ void ph_act(const Args& a) {
    unsigned char* ws = a.ws;
    const bf16* G = (const bf16*)(ws + WS_G); bf16* U = (bf16*)(ws + WS_U);
    const int gt = blockIdx.x * 512 + threadIdx.x, NT = gridDim.x * 512;
    constexpr int RUN = 8;
    for (int it = gt; it < (MX / RUN) * NCG; it += NT) {
        const int cgp = it % NCG, run = it / NCG, t0 = run * RUN;
        const bf16* gp = G + (size_t)t0 * DFF + 8 * cgp; bf16* up = U + (size_t)t0 * DFF + 8 * cgp;
        v4u gv[RUN + 2], uv[RUN];
        gv[0] = (v4u){0u, 0u, 0u, 0u}; gv[RUN + 1] = (v4u){0u, 0u, 0u, 0u};
        if ((t0 & 4095) != 0) gv[0] = *(const v4u*)(gp - DFF);
        if (((t0 + RUN) & 4095) != 0) gv[RUN + 1] = *(const v4u*)(gp + (size_t)RUN * DFF);
#pragma unroll
        for (int i = 0; i < RUN; ++i) { gv[i + 1] = *(const v4u*)(gp + (size_t)i * DFF); uv[i] = *(const v4u*)(up + (size_t)i * DFF); }
        const float* cw = a.in[19] + 8 * cgp;
        float w[3][8];
#pragma unroll
        for (int j = 0; j < 3; ++j) { const f32x4 w0 = *(const f32x4*)(cw + j * DFF), w1 = *(const f32x4*)(cw + j * DFF + 4); w[j][0] = w0.x; w[j][1] = w0.y; w[j][2] = w0.z; w[j][3] = w0.w; w[j][4] = w1.x; w[j][5] = w1.y; w[j][6] = w1.z; w[j][7] = w1.w; }
#pragma unroll
        for (int i = 0; i < RUN; ++i) {
            const v4u prev = gv[i], curv = gv[i + 1], nx = gv[i + 2], uu = uv[i];
            const float p[8] = {bflo(prev.x), bfhi(prev.x), bflo(prev.y), bfhi(prev.y), bflo(prev.z), bfhi(prev.z), bflo(prev.w), bfhi(prev.w)};
            const float c[8] = {bflo(curv.x), bfhi(curv.x), bflo(curv.y), bfhi(curv.y), bflo(curv.z), bfhi(curv.z), bflo(curv.w), bfhi(curv.w)};
            const float q[8] = {bflo(nx.x), bfhi(nx.x), bflo(nx.y), bfhi(nx.y), bflo(nx.z), bfhi(nx.z), bflo(nx.w), bfhi(nx.w)};
            const float uf[8] = {bflo(uu.x), bfhi(uu.x), bflo(uu.y), bfhi(uu.y), bflo(uu.z), bfhi(uu.z), bflo(uu.w), bfhi(uu.w)};
            float r[8];
#pragma unroll
            for (int e = 0; e < 8; ++e) r[e] = silu_f(w[0][e] * p[e] + w[1][e] * c[e] + w[2][e] * q[e]) * uf[e];
            v4u o; o.x = pk2(r[0], r[1]); o.y = pk2(r[2], r[3]); o.z = pk2(r[4], r[5]); o.w = pk2(r[6], r[7]);
            *(v4u*)(up + (size_t)i * DFF) = o;
        }
    }
}

__device__ __forceinline__ void ph_final(const Args& a) {
    const int tid = threadIdx.x, lane = tid & 63, wave = tid >> 6;
    unsigned char* ws = a.ws;
    const float* MOD = (const float*)(ws + WS_MOD);
    const bf16* Y2 = (const bf16*)(ws + WS_Y2);
    const int gw = blockIdx.x * 8 + wave, NGW = gridDim.x * 8;
    constexpr int R = 4;
    for (int t0 = gw * R; t0 < MX; t0 += NGW * R) {
        const int b = t0 >> 12;
        f32x4 xv[R][4]; v2u yv[R][4];
#pragma unroll
        for (int r = 0; r < R; ++r)
#pragma unroll
            for (int j = 0; j < 4; ++j) { const v2u xb = __builtin_nontemporal_load((const v2u*)((const bf16*)(ws + WS_X1) + (size_t)(t0 + r) * D) + lane + 64 * j); xv[r][j] = (f32x4){bflo(xb.x), bfhi(xb.x), bflo(xb.y), bfhi(xb.y)}; yv[r][j] = __builtin_nontemporal_load((const v2u*)(Y2 + (size_t)(t0 + r) * D) + lane + 64 * j); }
        f32x4 GG[4];
#pragma unroll
        for (int j = 0; j < 4; ++j) GG[j] = ((const f32x4*)a.in[9])[lane + 64 * j] * ((const f32x4*)(MOD + b * 6144 + 5120))[lane + 64 * j];
#pragma unroll
        for (int r = 0; r < R; ++r) {
            f32x4 y[4]; float s = 0.f;
#pragma unroll
            for (int j = 0; j < 4; ++j) { const v2u q = yv[r][j]; y[j] = (f32x4){bflo(q.x), bfhi(q.x), bflo(q.y), bfhi(q.y)}; s += (y[j].x * y[j].x + y[j].y * y[j].y) + (y[j].z * y[j].z + y[j].w * y[j].w); }
            const float r1 = rsq_f(wave_sum(s) * (1.f / D) + 1e-6f);
            f32x4* orow = (f32x4*)(a.out + (size_t)(t0 + r) * D) + lane;
#pragma unroll
            for (int j = 0; j < 4; ++j) __builtin_nontemporal_store(xv[r][j] + GG[j] * (y[j] * r1), orow + 64 * j);
        }
    }
}

typedef GAS unsigned gu32;
#define XB_TMO      128
#define XB_XCNT(j)  (256  + 64 * (j))
#define XB_XSUB(j)  (1280 + 64 * (j))
#define XB_XGEN(j)  (2304 + 64 * (j))
#define XB_TOP      3328
#define XB_TOPGEN   3392
#define XCD_BAR_WORDS 3456
#define XB_SPIN_CAP (1u << 18)

__device__ __forceinline__ unsigned xb_ld(unsigned* p)              { return __hip_atomic_load(p, __ATOMIC_RELAXED, __HIP_MEMORY_SCOPE_AGENT); }
__device__ __forceinline__ unsigned xb_add(unsigned* p, unsigned v) { return __hip_atomic_fetch_add(p, v, __ATOMIC_RELAXED, __HIP_MEMORY_SCOPE_AGENT); }
__device__ __forceinline__ unsigned xb_xcc_id() { return (unsigned)__builtin_amdgcn_s_getreg((3 << 11) | 20) & 0xFu; }
#define XB_SPIN(cond, bar) do { unsigned _sp = 0; while (cond) { __builtin_amdgcn_s_sleep(1); \
    if ((++_sp & 255u) == 0u) { if (xb_ld(&(bar)[XB_TMO])) break; if (_sp > XB_SPIN_CAP) { atomicAdd(&(bar)[XB_TMO], 1u); break; } } } } while (0)

struct XcdBarrier {
    unsigned* bar; unsigned x;
    volatile LAS unsigned* st;
};

__device__ __forceinline__ XcdBarrier xcd_barrier_post(unsigned* bar, volatile LAS unsigned* st) {
    XcdBarrier b; b.bar = bar; b.x = xb_xcc_id(); b.st = st;
    if (threadIdx.x == 0) (void)xb_add(&bar[XB_XCNT(b.x)], 1u);
    return b;
}
__device__ __forceinline__ void xcd_barrier_complete(unsigned* bar, unsigned x, unsigned& nloc, unsigned& nx) {
    const unsigned G = gridDim.x * gridDim.y * gridDim.z;
    unsigned sum, cnt, mine, sp = 0u;
    for (;;) {
        sum = 0u; cnt = 0u; mine = 0u;
#pragma unroll
        for (unsigned j = 0; j < 16; ++j) { const unsigned c = xb_ld(&bar[XB_XCNT(j)]); sum += c; cnt += (c > 0u) ? 1u : 0u; mine = (j == x) ? c : mine; }
        if (sum == G) break;
        __builtin_amdgcn_s_sleep(1);
        if ((++sp & 255u) == 0u) { if (xb_ld(&bar[XB_TMO])) break; if (sp > XB_SPIN_CAP) { atomicAdd(&bar[XB_TMO], 1u); break; } }
    }
    nloc = mine > 0u ? mine : 1u; nx = cnt > 0u ? cnt : 1u;
}

__device__ __forceinline__ void xcd_barrier(const XcdBarrier& b) {
    asm volatile("s_waitcnt vmcnt(0)" ::: "memory");
    __syncthreads();
    if (threadIdx.x == 0) {
        unsigned* bar = b.bar;
        __builtin_amdgcn_s_waitcnt(0);
        unsigned nloc = b.st[0], nx = b.st[1];
        if (nloc == 0u) { xcd_barrier_complete(bar, b.x, nloc, nx); b.st[0] = nloc; b.st[1] = nx; }
        const unsigned old = xb_add(&bar[XB_XSUB(b.x)], 1u);
        const unsigned gen = old / nloc;
        if (old + 1u == (gen + 1u) * nloc) {
            __builtin_amdgcn_fence(__ATOMIC_RELEASE, "agent");
            asm volatile("s_waitcnt vmcnt(0)" ::: "memory");
            const unsigned og = xb_add(&bar[XB_TOP], 1u);
            const unsigned tg = og / nx;
            if (og + 1u == (tg + 1u) * nx) xb_add(&bar[XB_TOPGEN], 1u);
            else XB_SPIN(xb_ld(&bar[XB_TOPGEN]) == tg, bar);
            __builtin_amdgcn_fence(__ATOMIC_ACQUIRE, "agent");
            xb_add(&bar[XB_XGEN(b.x)], 1u);
            asm volatile("s_waitcnt vmcnt(0)" ::: "memory");
        } else {
            XB_SPIN(xb_ld(&bar[XB_XGEN(b.x)]) == gen, bar);
            __builtin_amdgcn_fence(__ATOMIC_ACQUIRE, "agent");
            asm volatile("s_waitcnt vmcnt(0)" ::: "memory");
        }
    }
    __syncthreads();
}

constexpr int NPH = 12;
__global__ void __launch_bounds__(512, 2) mega_fwd(Args a) {
    extern __shared__ __attribute__((aligned(16))) unsigned char lds_raw[];
    LAS unsigned char* lds = (LAS unsigned char*)lds_raw;
    cg::grid_group grid = cg::this_grid();
    unsigned char* ws = a.ws;
    if (threadIdx.x < 64) ((LAS unsigned*)(lds + LDS_CTL))[threadIdx.x] = 0u;
    __syncthreads();
    XcdBarrier bar = xcd_barrier_post((unsigned*)ws, (volatile LAS unsigned*)(lds + LDS_CTL + 64));
    const int lo = a.ph_lo, hi = a.ph_hi;
#ifndef PHMASK
#define PHMASK 0xFFF
#endif
#define IN(k) (((PHMASK >> (k)) & 1) && lo <= (k) && (k) < hi)
#ifndef DUP_MASK
#define DUP_MASK 0
#endif
#define REP(k) for (int rep_ = 0; rep_ < ((((DUP_MASK) >> (k)) & 1) ? 2 : 1); ++rep_)
#define REPBAR() do { if (rep_) xcd_barrier(bar); } while (0)
#define SEAM(k) do { if (IN(k) && IN((k) + 1)) xcd_barrier(bar); } while (0)
    if (a.ph_lo < 0) grid.sync();
    if (IN(0)) REP(0) { REPBAR(); ph_prologue(a, lds); }
    SEAM(0);
    if (IN(1)) REP(1) { REPBAR(); ph_norm1(a, lds); }
    SEAM(1);
    if (IN(2)) REP(2) {   REPBAR();
        pg8::Gemm g{(const bf16*)(ws + WS_XN), (const bf16*)(ws + WS_WIN), MX, 2560, 1024}; pg8::StaticOrder S; S.init(MX, 2560, (int)gridDim.x, (int)blockIdx.x);
        pg8::EpiBf16<0> E{(bf16*)(ws + WS_P), 512, nullptr, 512, P_SPLIT, 1.f};
        pg8::gemm_phase<pg8::EpiBf16<0>, pg8::StaticOrder, true, true>(lds, g, S, E);
    }
    SEAM(2);
    if (IN(3)) REP(3) { REPBAR();
#ifndef P3_PREP_REPS
#define P3_PREP_REPS 1
#endif
#ifndef P3_POOL_REPS
#define P3_POOL_REPS 1
#endif
        unsigned* cflag = (unsigned*)ws + 3600;
        const int G = (int)gridDim.x, bid = (int)blockIdx.x;
        const bool cw_lds = (G & 3) == 0;
        if (cw_lds) { for (int idx = threadIdx.x; idx < 1920; idx += 512) { const int X = idx / 640, j = (idx / 128) % 5, c = idx & 127; ((LAS float*)(lds + LDS_CW))[idx] = a.in[11][j * 1536 + X * 512 + (bid & 3) * 128 + c]; } __syncthreads(); }
        if (G >= 160) {
            if (bid < 32) {
                pg8::Gemm g{(const bf16*)(ws + WS_YIN), (const bf16*)(ws + WS_WIN) + (size_t)512 * 1024, MC, 1024, 1024}; pg8::StaticOrder S; S.init(MC, 1024, 32, bid);
                pg8::EpiBf16<0> E{(bf16*)(ws + WS_P) + P_SPLIT + (size_t)MX * 512, 512, nullptr, 512, P_SPLIT, 1.f};
                pg8::gemm_phase<pg8::EpiBf16<0>, pg8::StaticOrder, true, true>(lds, g, S, E);
                __threadfence(); __syncthreads();
                if (threadIdx.x == 0) __hip_atomic_fetch_add(cflag, 1u, __ATOMIC_RELEASE, __HIP_MEMORY_SCOPE_AGENT);
            }
            {
              const bool rebal = (G == 256);
              const int xlim = (rebal && bid < 32) ? 1792 : 2048;
              const int extra = (rebal && bid >= 160 && bid < 192) ? 1792 + (bid - 160) : -1;
              v4u ldv[3][6]; prep_load(a, bid, ldv);
              for (int it = bid; it < xlim; it += G) prep_item(a, lds, it, ldv, it + G < xlim ? it + G : extra);
              if (extra >= 0) prep_item(a, lds, extra, ldv, -1); }
            for (int it = bid - 32; it >= 0 && it < 128; it += G) {
                if (threadIdx.x == 0) { unsigned sp = 0; while (__hip_atomic_load(cflag, __ATOMIC_RELAXED, __HIP_MEMORY_SCOPE_AGENT) < 32u && ++sp < (1u << 22)) __builtin_amdgcn_s_sleep(4); }
                __syncthreads();
                __builtin_amdgcn_fence(__ATOMIC_ACQUIRE, "agent");
                { v4u ldv[3][6]; prep_load(a, 2048 + it, ldv); prep_item(a, lds, 2048 + it, ldv, -1); }
            }
        } else {
            for (int u0 = bid; u0 < 32; u0 += G) {
                pg8::Gemm g{(const bf16*)(ws + WS_YIN), (const bf16*)(ws + WS_WIN) + (size_t)512 * 1024, MC, 1024, 1024}; pg8::StaticOrder S; S.init(MC, 1024, 32, u0);
                pg8::EpiBf16<0> E{(bf16*)(ws + WS_P) + P_SPLIT + (size_t)MX * 512, 512, nullptr, 512, P_SPLIT, 1.f};
                pg8::gemm_phase<pg8::EpiBf16<0>, pg8::StaticOrder, true, true>(lds, g, S, E);
            }
            xcd_barrier(bar);
            for (int it = bid; it < 2176; it += G) { v4u ldv[3][6]; prep_load(a, it, ldv); prep_item(a, lds, it, ldv, -1); }
        }
    }
    SEAM(3);
#ifndef SCAN_PROBE_MODE
#define SCAN_PROBE_MODE 0
#endif
    if (IN(4)) REP(4) { REPBAR();
        const int G = (int)gridDim.x, nscan = G >= 256 ? 128 : G;
        if ((int)blockIdx.x < nscan) { if (rep_ == 0) ph_scan<0>(a, lds, nscan); else ph_scan<SCAN_PROBE_MODE>(a, lds, nscan); }
        if (G < 256 || (int)blockIdx.x >= nscan) {
            const int ob = G >= 256 ? (int)blockIdx.x - nscan : (int)blockIdx.x, on = G >= 256 ? G - nscan : G;
            for (int it = ob; it < 2048; it += on) pool_item(a, lds, it);
            late_weights(a, lds, ob * 8 + (int)(threadIdx.x >> 6), on * 8);
        }
    }
    SEAM(4);
    if (IN(5)) REP(5) { REPBAR(); for (int it = blockIdx.x; it < 1024; it += gridDim.x) out_pair(a, lds, it); }
    SEAM(5);
    if (IN(6)) REP(6) {   REPBAR();
        pg8::Gemm g{(const bf16*)(ws + WS_YIN), (const bf16*)(ws + WS_WOUT), MX, 1024, 1024}; pg8::StaticOrder S; S.init(MX, 1024, (int)gridDim.x, (int)blockIdx.x);
        pg8::EpiBf16<0> E{(bf16*)(ws + WS_YX), 1024, nullptr, 0, 0, 1.f};
        pg8::gemm_phase<pg8::EpiBf16<0>, pg8::StaticOrder, true, true>(lds, g, S, E);
    }
    SEAM(6);
    if (IN(7)) REP(7) { REPBAR(); ph_mid(a); }
    SEAM(7);
    if (IN(8)) REP(8) {   REPBAR();
        pg8::Gemm g{(const bf16*)(ws + WS_XN), (const bf16*)(ws + WS_WUP), MX, DFF + 256, 1024}; pg8::StaticOrder S; S.init(MX, DFF + 256, (int)gridDim.x, (int)blockIdx.x);
        pg8::EpiBf16<0> E{(bf16*)(ws + WS_G), DFF, nullptr, DFF, (size_t)(WS_U - WS_G) / 2, 1.f};
        pg8::gemm_phase<pg8::EpiBf16<0>, pg8::StaticOrder, true, true>(lds, g, S, E);
    }
    SEAM(8);
    if (IN(9)) {
        ph_act<32>(a);
        pg8::Gemm g{(const bf16*)(ws + WS_XN), (const bf16*)(ws + WS_WUP) + (size_t)(DFF + 256) * 1024, MX, DFF - 256, 1024}; pg8::StaticOrder S; S.init(MX, DFF - 256, (int)gridDim.x, (int)blockIdx.x);
        pg8::EpiAct E{(const bf16*)(ws + WS_G) + 256, (bf16*)(ws + WS_U) + 256, DFF, a.in[19] + 256};
        pg8::gemm_phase<pg8::EpiAct, pg8::StaticOrder, true, true>(lds, g, S, E);
    }
    SEAM(9);
    if (IN(10)) REP(10) {  REPBAR();
        pg8::Gemm g{(const bf16*)(ws + WS_U), (const bf16*)(ws + WS_WDOWN), MX, 1024, DFF}; pg8::StaticOrder S; S.init(MX, 1024, (int)gridDim.x, (int)blockIdx.x);
        pg8::EpiBf16<0> E{(bf16*)(ws + WS_Y2), 1024, nullptr, 0, 0, 1.f};
        pg8::gemm_phase<pg8::EpiBf16<0>, pg8::StaticOrder, true, true>(lds, g, S, E);
    }
    SEAM(10);
    if (IN(11)) ph_final(a);
#undef IN
#undef SEAM
}

#ifndef MK_LAUNCHES
#define MK_LAUNCHES 1
#endif
extern "C" void kernel_launch(void* const* d_in, const int* in_sizes, int n_in, void* d_out, int out_size, void* d_ws, size_t ws_size, hipStream_t stream) {
    static int grid = 0;
    if (grid == 0) {
        int dev = 0, cus = 0, per_cu = 0;
        hipGetDevice(&dev);
        hipDeviceGetAttribute(&cus, hipDeviceAttributeMultiprocessorCount, dev);
        if (hipFuncSetAttribute((const void*)mega_fwd, hipFuncAttributeMaxDynamicSharedMemorySize, LDS_BYTES) != hipSuccess) { fprintf(stderr, "kernel_launch: hipFuncSetAttribute failed\n"); grid = -1; return; }
        if (hipOccupancyMaxActiveBlocksPerMultiprocessor(&per_cu, (const void*)mega_fwd, 512, LDS_BYTES) != hipSuccess || per_cu < 1) { fprintf(stderr, "kernel_launch: occupancy query failed (%d)\n", per_cu); per_cu = 1; }
        (void)hipGetLastError();
        grid = cus * 1;
        if (per_cu < 1 || cus < 1) grid = -1;
        if (ws_size < (size_t)512 * MiB) { fprintf(stderr, "kernel_launch: workspace too small: %zu\n", ws_size); grid = -1; }
    }
    if (grid < 0) return;
    if (hipMemsetAsync(d_ws, 0, 16384, stream) != hipSuccess) { fprintf(stderr, "kernel_launch: memset failed\n"); return; }
    Args a{};
    for (int i = 0; i < 21; ++i) a.in[i] = (const float*)d_in[i];
    a.out = (float*)d_out; a.ws = (unsigned char*)d_ws;
#if MK_LAUNCHES == 1
    a.ph_lo = 0; a.ph_hi = NPH;
    void* args[] = {&a};
    hipError_t e = hipLaunchCooperativeKernel((const void*)mega_fwd, dim3(grid), dim3(512), args, LDS_BYTES, stream);
    if (e != hipSuccess) fprintf(stderr, "cooperative launch failed: %s (grid %d)\n", hipGetErrorString(e), grid);
#else
    for (int p = 0; p < NPH; ++p) { a.ph_lo = p; a.ph_hi = p + 1; hipLaunchKernelGGL(mega_fwd, dim3(grid), dim3(512), LDS_BYTES, stream, a); }
#endif
}
```

```cpp
#include <hip/hip_runtime.h>
#include <hip/hip_cooperative_groups.h>
#include <cstdio>
#include <cstdint>
namespace cg = cooperative_groups;
namespace pg8 {
#define PG8_LAS __attribute__((address_space(3)))
typedef unsigned short bf16_t;
typedef short bf16x8 __attribute__((ext_vector_type(8)));
typedef float f32x4 __attribute__((ext_vector_type(4)));
typedef unsigned u32x4 __attribute__((ext_vector_type(4)));
constexpr int BM = 256, BK = 64, HALF = 128, HTB = HALF * BK * 2  , STAGE_BYTES = 8 * HTB, NXCD = 8, WGM = 8;

__host__ __device__ __forceinline__ int lds_byte(int r, int c) { const int st = (r >> 4) * 2 + (c >> 5), rr = r & 15, cc = c & 31, ob = rr * 64 + cc * 2; return st * 1024 + (ob ^ (((ob >> 9) & 1) << 5)); }
__host__ __device__ __forceinline__ void stage_rc(int b, int& R, int& C) { const int st = b / 1024, sb = b % 1024, swz = sb ^ (((sb >> 9) & 1) << 5); R = (st >> 1) * 16 + swz / 64; C = (st & 1) * 32 + (swz % 64) / 2; }
__host__ __device__ __forceinline__ int perm32(int rho) { const int n = rho >> 4, i = rho & 15; return 8 * (i >> 2) + 4 * n + (i & 3); }

struct Unit { int pm, pn; };
struct Gemm { const bf16_t* A; const bf16_t* Bt; int M, N, K; };

struct StaticOrder {
    int nM, nN, nwg, G, c;
    __host__ __device__ void init(int M, int N, int G_, int c_) { nM = M / BM; nN = N / BM; nwg = nM * nN; G = G_; c = c_; }
    __host__ __device__ bool next(int i, Unit& u) const {
        const long L = (long)i * G + c; if (L >= nwg) return false;
        int wgid = (int)L; { const int q = nwg / NXCD, r = nwg % NXCD, xcd = wgid % NXCD, off = wgid / NXCD; wgid = (xcd < r ? xcd * (q + 1) : r * (q + 1) + (xcd - r) * q) + off; }
        const int nig = WGM * nN, gid = wgid / nig, fm = gid * WGM, gsz = (nM - fm) < WGM ? (nM - fm) : WGM;
        u.pm = fm + ((wgid % nig) % gsz); u.pn = (wgid % nig) / gsz; return true;
    }
    __device__ __forceinline__ void a_ready(const Unit&) const {}
    __device__ __forceinline__ void done(const Unit&) const {}
};

typedef __bf16 pg8_bf16x2 __attribute__((ext_vector_type(2)));
__device__ __forceinline__ unsigned cvt_pk_bf16(float lo, float hi) { typedef float f2_ __attribute__((ext_vector_type(2))); const f2_ v = {lo, hi}; return __builtin_bit_cast(unsigned, __builtin_convertvector(v, pg8_bf16x2)); }
typedef float f32x2 __attribute__((ext_vector_type(2)));
__device__ __forceinline__ f32x2 gelu_pk(f32x2 v) {
    const f32x2 av = __builtin_elementwise_abs(v), d = av * 0.2316418882f + 1.0f;
    f32x2 t; t.x = __builtin_amdgcn_rcpf(d.x); t.y = __builtin_amdgcn_rcpf(d.y);
    f32x2 q = t * 0.5307027145f + (-0.7265760135f); q = q * t + 0.7107068705f; q = q * t + (-0.142248368f); q = q * t + 0.127414796f; q = q * t;
    const f32x2 s = (v * v) * (-0.72134752044f);
    f32x2 e; e.x = __builtin_amdgcn_exp2f(s.x); e.y = __builtin_amdgcn_exp2f(s.y);
    const f32x2 m = v * (q * e), r = v - m;
    f32x2 o; o.x = v.x < 0.f ? m.x : r.x; o.y = v.y < 0.f ? m.y : r.y; return o;
}

template <int ACT  > struct EpiBf16 {
    static constexpr bool PERM = true, AFTER_DRAIN = false; static_assert(ACT == 0 || ACT == 1, "EpiBf16: ACT is 0 (none) or 1 (gelu_pk)");
    bf16_t* O; int ldc; const float* bias; int split_cols; size_t split_stride; float scale0;
    __device__ __forceinline__ void operator()(const f32x4 (&acc)[2][2][4][2], const Unit& u, int wr, int wc, int fr, int fq) const {
        const int row0 = u.pm * BM + wr * 64 + fr; int colt = u.pn * BM; bf16_t* base = O;
        float sc = 1.f; if (split_cols) { const int t = colt / split_cols; base += (size_t)t * split_stride; colt -= t * split_cols; if (t == 0) sc = scale0; }
        const int col0 = colt + wc * 32 + 8 * fq, bcol0 = u.pn * BM + wc * 32 + 8 * fq;
        f32x4 bv[2][2];
#pragma unroll
        for (int bj = 0; bj < 2; ++bj)
#pragma unroll
            for (int n = 0; n < 2; ++n) bv[bj][n] = bias ? *(const f32x4*)(bias + bcol0 + bj * HALF + 4 * n) : (f32x4){0.f, 0.f, 0.f, 0.f};
#pragma unroll
        for (int ai = 0; ai < 2; ++ai)
#pragma unroll
            for (int m = 0; m < 4; ++m) { bf16_t* rowp = base + (size_t)(row0 + ai * HALF + m * 16) * ldc + col0;
#pragma unroll
                for (int bj = 0; bj < 2; ++bj) { f32x4 v0 = acc[ai][bj][m][0] + bv[bj][0], v1 = acc[ai][bj][m][1] + bv[bj][1];
                    if (ACT == 1) { f32x2 a = gelu_pk((f32x2){v0[0], v0[1]}), b = gelu_pk((f32x2){v0[2], v0[3]}), c = gelu_pk((f32x2){v1[0], v1[1]}), d = gelu_pk((f32x2){v1[2], v1[3]});
                        v0 = (f32x4){a.x, a.y, b.x, b.y}; v1 = (f32x4){c.x, c.y, d.x, d.y}; }
                    v0 = v0 * sc; v1 = v1 * sc; u32x4 w; w.x = cvt_pk_bf16(v0[0], v0[1]); w.y = cvt_pk_bf16(v0[2], v0[3]); w.z = cvt_pk_bf16(v1[0], v1[1]); w.w = cvt_pk_bf16(v1[2], v1[3]);
                    *(u32x4*)(rowp + bj * HALF) = w; } }
    }
};
struct EpiAct {
    static constexpr bool PERM = true, AFTER_DRAIN = false;
    const bf16_t* G; bf16_t* O; int ldc; const float* cw;
    __device__ __forceinline__ void operator()(const f32x4 (&acc)[2][2][4][2], const Unit& u, int wr, int wc, int fr, int fq) const {
        const int row0 = u.pm * BM + wr * 64 + fr, col0 = u.pn * BM + wc * 32 + 8 * fq;
#pragma unroll
        for (int bj = 0; bj < 2; ++bj) {
            const int c = col0 + bj * HALF;
            float w[3][8];
#pragma unroll
            for (int j = 0; j < 3; ++j) { const f32x4 w0 = *(const f32x4*)(cw + (size_t)j * ldc + c), w1 = *(const f32x4*)(cw + (size_t)j * ldc + c + 4);
                w[j][0] = w0[0]; w[j][1] = w0[1]; w[j][2] = w0[2]; w[j][3] = w0[3]; w[j][4] = w1[0]; w[j][5] = w1[1]; w[j][6] = w1[2]; w[j][7] = w1[3]; }
#pragma unroll
            for (int ai = 0; ai < 2; ++ai)
#pragma unroll
                for (int m = 0; m < 4; ++m) {
                    const int r = row0 + ai * HALF + m * 16;
                    const bf16_t* gp = G + (size_t)r * ldc + c;
                    u32x4 pv = (u32x4){0u, 0u, 0u, 0u}, nv = pv;
                    if ((r & 4095) != 0) pv = *(const u32x4*)(gp - ldc);
                    if (((r + 1) & 4095) != 0) nv = *(const u32x4*)(gp + ldc);
                    const u32x4 cv = *(const u32x4*)gp;
                    const f32x4 v0 = acc[ai][bj][m][0], v1 = acc[ai][bj][m][1];
                    const float up[8] = {v0[0], v0[1], v0[2], v0[3], v1[0], v1[1], v1[2], v1[3]};
                    float o[8];
#pragma unroll
                    for (int q = 0; q < 4; ++q) {
                        const float p0 = __builtin_bit_cast(float, pv[q] << 16), p1 = __builtin_bit_cast(float, pv[q] & 0xffff0000u);
                        const float c0 = __builtin_bit_cast(float, cv[q] << 16), c1 = __builtin_bit_cast(float, cv[q] & 0xffff0000u);
                        const float n0 = __builtin_bit_cast(float, nv[q] << 16), n1 = __builtin_bit_cast(float, nv[q] & 0xffff0000u);
                        const float s0 = w[0][2 * q] * p0 + w[1][2 * q] * c0 + w[2][2 * q] * n0, s1 = w[0][2 * q + 1] * p1 + w[1][2 * q + 1] * c1 + w[2][2 * q + 1] * n1;
                        o[2 * q] = s0 * __builtin_amdgcn_rcpf(1.f + __expf(-s0)) * up[2 * q]; o[2 * q + 1] = s1 * __builtin_amdgcn_rcpf(1.f + __expf(-s1)) * up[2 * q + 1]; }
                    u32x4 wv; wv.x = cvt_pk_bf16(o[0], o[1]); wv.y = cvt_pk_bf16(o[2], o[3]); wv.z = cvt_pk_bf16(o[4], o[5]); wv.w = cvt_pk_bf16(o[6], o[7]);
                    *(u32x4*)(O + (size_t)r * ldc + c) = wv;
                }
        }
    }
};

template <class Epi, class Sched, bool ALIGN_EPI = false, bool SP2 = false>
__device__ __forceinline__ void gemm_phase(PG8_LAS unsigned char* lds, const Gemm g, const Sched& S, const Epi& E) {
    const int tid = threadIdx.x, wid = __builtin_amdgcn_readfirstlane(tid >> 6), lane = tid & 63, wr = wid >> 2, wc = wid & 3, fr = lane & 15, fq = lane >> 4;
    const int K = g.K, nt = K / BK;
    unsigned voffA[2], voffB[2];
#pragma unroll
    for (int i = 0; i < 2; ++i) { int R, C; stage_rc(tid * 16 + i * 8192, R, C); const int Rb = Epi::PERM ? ((R & ~31) + perm32(R & 31)) : R;
        voffA[i] = (unsigned)(R * K + C) * 2u; voffB[i] = (unsigned)(Rb * K + C) * 2u; }
    const size_t kstep = (size_t)(BK * 2);
    const size_t hstep = (size_t)HALF * K * 2;
    const size_t tstep = 2 * hstep;
    const unsigned ldsw = (unsigned)wid * 1024u;
    const int aoff = lds_byte(wr * 64 + fr, fq * 8), boff = lds_byte(wc * 32 + fr, fq * 8);
#define PG8_SA(b, h) (((b) * 2 + (h)) * HTB)
#define PG8_SB(b, h) ((4 + (b) * 2 + (h)) * HTB)
#define PG8_STAGE(bufoff, gbase, voff) do { _Pragma("unroll") for (int _i = 0; _i < 2; ++_i) \
        __builtin_amdgcn_global_load_lds((const unsigned*)((const char*)(gbase) + (voff)[_i]), (PG8_LAS unsigned*)(lds + (bufoff) + ldsw + _i * 8192), 16, 0, 0); } while (0)
#define PG8_LDA(dst, b, h) do { _Pragma("unroll") for (int m = 0; m < 4; ++m) _Pragma("unroll") for (int k = 0; k < 2; ++k) dst[m][k] = *(const PG8_LAS bf16x8*)(lds + PG8_SA(b, h) + aoff + m * 2048 + k * 1024); } while (0)
#define PG8_LDB(dst, b, h) do { _Pragma("unroll") for (int n = 0; n < 2; ++n) _Pragma("unroll") for (int k = 0; k < 2; ++k) dst[n][k] = *(const PG8_LAS bf16x8*)(lds + PG8_SB(b, h) + boff + n * 2048 + k * 1024); } while (0)
#define PG8_MMA(ai, bj, At, Bt) do { __builtin_amdgcn_s_setprio(1); _Pragma("unroll") for (int m = 0; m < 4; ++m) _Pragma("unroll") for (int n = 0; n < 2; ++n) _Pragma("unroll") for (int k = 0; k < 2; ++k) \
        acc[ai][bj][m][n] = __builtin_amdgcn_mfma_f32_16x16x32_bf16(Bt[n][k], At[m][k], acc[ai][bj][m][n], 0, 0, 0); __builtin_amdgcn_s_setprio(0); } while (0)
#define PG8_WAIT_V(n) asm volatile("s_waitcnt vmcnt(" #n ")" ::: "memory")
#define PG8_WAIT_L(n) asm volatile("s_waitcnt lgkmcnt(" #n ")" ::: "memory")
#define PG8_BAR __builtin_amdgcn_s_barrier()
#define PG8_SCHED __builtin_amdgcn_sched_barrier(0)
    Unit cur, nxt; int ui = 0;
    if (!S.next(0, cur)) return;
    f32x4 acc[2][2][4][2];
#pragma unroll
    for (int a = 0; a < 2; ++a)
#pragma unroll
        for (int b = 0; b < 2; ++b)
#pragma unroll
            for (int m = 0; m < 4; ++m)
#pragma unroll
                for (int n = 0; n < 2; ++n) acc[a][b][m][n] = (f32x4){0.f, 0.f, 0.f, 0.f};
    bf16x8 At[4][2], B0[2][2], B1[2][2];
    const char* cA = (const char*)g.A + (size_t)cur.pm * tstep; const char* cB = (const char*)g.Bt + (size_t)cur.pn * tstep;
    S.a_ready(cur);
    if constexpr (SP2) {
        PG8_STAGE(PG8_SB(0, 0), cB, voffB); PG8_STAGE(PG8_SB(0, 1), cB + hstep, voffB); PG8_STAGE(PG8_SA(0, 0), cA, voffA); PG8_STAGE(PG8_SA(0, 1), cA + hstep, voffA);
        if (wr == 1) PG8_BAR;
        PG8_WAIT_V(2); PG8_BAR;
        PG8_STAGE(PG8_SB(1, 0), cB + kstep, voffB); PG8_STAGE(PG8_SA(1, 0), cA + kstep, voffA); PG8_STAGE(PG8_SB(1, 1), cB + hstep + kstep, voffB);
        PG8_WAIT_V(6); PG8_BAR;
    } else {
        PG8_STAGE(PG8_SB(0, 0), cB, voffB); PG8_STAGE(PG8_SA(0, 0), cA, voffA); PG8_STAGE(PG8_SB(0, 1), cB + hstep, voffB); PG8_STAGE(PG8_SA(0, 1), cA + hstep, voffA);
        if (wr == 1) PG8_BAR;
        PG8_WAIT_V(4); PG8_BAR;
        PG8_STAGE(PG8_SB(1, 0), cB + kstep, voffB); PG8_STAGE(PG8_SA(1, 0), cA + kstep, voffA); PG8_STAGE(PG8_SB(1, 1), cB + hstep + kstep, voffB);
        PG8_WAIT_V(6); PG8_BAR;
    }
    for (;;) {
        const bool has_next = S.next(ui + 1, nxt);
        const char* nA = has_next ? (const char*)g.A + (size_t)nxt.pm * tstep : cA; const char* nB = has_next ? (const char*)g.Bt + (size_t)nxt.pn * tstep : cB;
        for (int t = 0; t < nt; t += 2) {
            const bool last = (t == nt - 2);
            const char* a1 = cA + (size_t)(t + 1) * kstep;
            const char* a2 = last ? nA : cA + (size_t)(t + 2) * kstep; const char* b2 = last ? nB : cB + (size_t)(t + 2) * kstep;
            const char* a3 = a2 + kstep; const char* b3 = b2 + kstep;
            if (last && has_next) S.a_ready(nxt);
            if constexpr (SP2) {
            PG8_LDB(B0, 0, 0); PG8_LDB(B1, 0, 1); PG8_SCHED; PG8_LDA(At, 0, 0); PG8_STAGE(PG8_SA(1, 1), a1 + hstep, voffA);
            PG8_WAIT_V(8); PG8_WAIT_L(0); PG8_BAR; PG8_MMA(0, 0, At, B0); PG8_MMA(0, 1, At, B1); PG8_BAR; PG8_SCHED;
            PG8_LDA(At, 0, 1); PG8_STAGE(PG8_SB(0, 0), b2, voffB); PG8_STAGE(PG8_SB(0, 1), b2 + hstep, voffB); PG8_STAGE(PG8_SA(0, 0), a2, voffA);
            PG8_WAIT_V(8); PG8_WAIT_L(0); PG8_BAR; PG8_MMA(1, 0, At, B0); PG8_MMA(1, 1, At, B1); PG8_BAR; PG8_SCHED;
            PG8_LDB(B0, 1, 0); PG8_LDB(B1, 1, 1); PG8_SCHED; PG8_LDA(At, 1, 0); PG8_STAGE(PG8_SA(0, 1), a2 + hstep, voffA);
            PG8_WAIT_V(8); PG8_WAIT_L(0); PG8_BAR; PG8_MMA(0, 0, At, B0); PG8_MMA(0, 1, At, B1); PG8_BAR; PG8_SCHED;
            PG8_LDA(At, 1, 1); PG8_STAGE(PG8_SB(1, 0), b3, voffB); PG8_STAGE(PG8_SB(1, 1), b3 + hstep, voffB); PG8_STAGE(PG8_SA(1, 0), a3, voffA);
            PG8_WAIT_V(8); PG8_WAIT_L(0); PG8_BAR; PG8_MMA(1, 0, At, B0); PG8_MMA(1, 1, At, B1); PG8_BAR; PG8_SCHED;
            } else {
            PG8_LDB(B0, 0, 0); PG8_SCHED; PG8_LDA(At, 0, 0); PG8_STAGE(PG8_SA(1, 1), a1 + hstep, voffA);
            PG8_WAIT_L(8); PG8_BAR; PG8_WAIT_L(0); PG8_MMA(0, 0, At, B0); PG8_BAR; PG8_SCHED;
            PG8_LDB(B1, 0, 1); PG8_STAGE(PG8_SB(0, 0), b2, voffB);
            PG8_BAR; PG8_WAIT_L(0); PG8_MMA(0, 1, At, B1); PG8_BAR;
            PG8_LDA(At, 0, 1); PG8_STAGE(PG8_SA(0, 0), a2, voffA);
            PG8_BAR; PG8_WAIT_L(0); PG8_MMA(1, 0, At, B0); PG8_BAR; PG8_SCHED;
            PG8_STAGE(PG8_SB(0, 1), b2 + hstep, voffB);
            PG8_WAIT_V(6); PG8_BAR; PG8_MMA(1, 1, At, B1); PG8_BAR;
            PG8_LDB(B0, 1, 0); PG8_SCHED; PG8_LDA(At, 1, 0); PG8_STAGE(PG8_SA(0, 1), a2 + hstep, voffA);
            PG8_WAIT_L(8); PG8_BAR; PG8_WAIT_L(0); PG8_MMA(0, 0, At, B0); PG8_BAR; PG8_SCHED;
            PG8_LDB(B1, 1, 1); PG8_STAGE(PG8_SB(1, 0), b3, voffB);
            PG8_BAR; PG8_WAIT_L(0); PG8_MMA(0, 1, At, B1); PG8_BAR;
            PG8_LDA(At, 1, 1); PG8_STAGE(PG8_SA(1, 0), a3, voffA);
            PG8_BAR; PG8_WAIT_L(0); PG8_MMA(1, 0, At, B0); PG8_BAR; PG8_SCHED;
            PG8_STAGE(PG8_SB(1, 1), b3 + hstep, voffB);
            PG8_WAIT_V(6); PG8_BAR; PG8_MMA(1, 1, At, B1); PG8_BAR;
            }
        }
        if constexpr (ALIGN_EPI) { if (wr == 0) PG8_BAR; }
        if constexpr (!Epi::AFTER_DRAIN) { E(acc, cur, wr, wc, fr, fq); S.done(cur); }
        if (!has_next) break;
#pragma unroll
        for (int a = 0; a < 2; ++a)
#pragma unroll
            for (int b = 0; b < 2; ++b)
#pragma unroll
                for (int m = 0; m < 4; ++m)
#pragma unroll
                    for (int n = 0; n < 2; ++n) acc[a][b][m][n] = (f32x4){0.f, 0.f, 0.f, 0.f};
        cur = nxt; cA = nA; cB = nB; ++ui;
        if constexpr (ALIGN_EPI) { if (wr == 1) PG8_BAR; }
    }
    PG8_WAIT_V(0);
    if constexpr (!ALIGN_EPI) { if (wr == 0) PG8_BAR; }
    PG8_BAR;
    if constexpr (Epi::AFTER_DRAIN) { E.fused(acc, cur, wr, wc, fr, fq, lds, wid, lane); S.done(cur); }
#undef PG8_SA
#undef PG8_SB
#undef PG8_STAGE
#undef PG8_LDA
#undef PG8_LDB
#undef PG8_MMA
#undef PG8_WAIT_V
#undef PG8_WAIT_L
#undef PG8_BAR
#undef PG8_SCHED
}
}

#define GAS __attribute__((address_space(1)))
#define LAS __attribute__((address_space(3)))
typedef unsigned short bf16;
typedef unsigned v4u __attribute__((ext_vector_type(4)));
typedef unsigned v2u __attribute__((ext_vector_type(2)));
typedef float f32x4 __attribute__((ext_vector_type(4)));
typedef short bf16x8 __attribute__((ext_vector_type(8)));

constexpr int D = 1024, MX = 32768, MC = 2048, MT = 34816;
constexpr int INC = 2576, DFF = 2816;
constexpr size_t MiB = 1u << 20;
constexpr size_t WS_WIN = 1 * MiB, WS_WOUT = 6 * MiB + MiB / 2, WS_WUP = 9 * MiB, WS_WDOWN = 20 * MiB + MiB / 2, WS_WP = 26 * MiB + MiB / 2;
constexpr size_t WS_MOD = 27 * MiB, WS_GATES = 28 * MiB;
constexpr size_t WS_XN = 32 * MiB;
constexpr size_t WS_QN = 32 * MiB, WS_KT = 66 * MiB;
constexpr size_t WS_P = 100 * MiB;
constexpr size_t P_SPLIT = (size_t)MT * 512;
constexpr size_t WS_OF = 100 * MiB, WS_OB = 134 * MiB;
constexpr size_t WS_WC = 270 * MiB, WS_UT = 338 * MiB, WS_AT = 406 * MiB, WS_YIN = 440 * MiB;
constexpr size_t WS_YX = 270 * MiB;
constexpr size_t WS_G = 96 * MiB, WS_U = 272 * MiB;
constexpr size_t WS_X1 = 448 * MiB;
constexpr size_t WS_Y2 = 32 * MiB;
constexpr size_t WS_EG = 504 * MiB, WS_SD = 506 * MiB, WS_EGL = 508 * MiB;
constexpr int LDS_CTL = 147456;
constexpr int LDS_CW = LDS_CTL + 1024;
constexpr int LDS_BYTES = LDS_CW + 7680;

struct Args { const float* in[21]; float* out; unsigned char* ws; int ph_lo, ph_hi; };

__device__ __forceinline__ unsigned f2bf(float f) { unsigned u = __builtin_bit_cast(unsigned, f); return (u + 0x7fffu + ((u >> 16) & 1u)) >> 16; }
typedef float f32x2_t __attribute__((ext_vector_type(2)));
typedef __bf16 bf16x2_t __attribute__((ext_vector_type(2)));
__device__ __forceinline__ unsigned pk2(float lo, float hi) { const f32x2_t v = {lo, hi}; return __builtin_bit_cast(unsigned, __builtin_convertvector(v, bf16x2_t)); }
__device__ __forceinline__ float bflo(unsigned u) { return __builtin_bit_cast(float, u << 16); }
__device__ __forceinline__ float bfhi(unsigned u) { return __builtin_bit_cast(float, u & 0xffff0000u); }
__device__ __forceinline__ float bf2f(bf16 h) { return __builtin_bit_cast(float, (unsigned)h << 16); }
#define dpp_f(v, ctrl) __builtin_bit_cast(float, __builtin_amdgcn_update_dpp(0, __builtin_bit_cast(int, (v)), (ctrl), 0xf, 0xf, false))
__device__ __forceinline__ float sum16(float v) {
    v += dpp_f(v, 0xB1);
    v += dpp_f(v, 0x4E);
    v += dpp_f(v, 0x141);
    v += dpp_f(v, 0x140);
    return v;
}
__device__ __forceinline__ float wave_sum(float v) {
    v = sum16(v);
    v += __builtin_bit_cast(float, __builtin_amdgcn_update_dpp(0, __builtin_bit_cast(int, v), 0x142, 0xa, 0xf, false));
    v += __builtin_bit_cast(float, __builtin_amdgcn_update_dpp(0, __builtin_bit_cast(int, v), 0x143, 0xc, 0xf, false));
    return __builtin_bit_cast(float, __builtin_amdgcn_readlane(__builtin_bit_cast(int, v), 63));
}
__device__ __forceinline__ float silu_f(float v) { return v * __builtin_amdgcn_rcpf(1.f + __expf(-v)); }
__device__ __forceinline__ float rsq_f(float v) { return __builtin_amdgcn_rsqf(v); }
#define LDS_WAIT() asm volatile("s_waitcnt lgkmcnt(0)" ::: "memory")
#define LBAR() __syncthreads()
#define LBAR2() do { asm volatile("s_waitcnt lgkmcnt(0)" ::: "memory"); __builtin_amdgcn_s_barrier(); asm volatile("" ::: "memory"); } while (0)

__device__ __forceinline__ void tr_item(const float* W, int ldw, int c0, int K, bf16* WT, int r0, LAS float* scr, int kb, int nb, int lane) {
    const int k0 = 64 * kb, n0 = 32 * nb;
    float tv[32];
    const float* Wp_ = W + (size_t)(k0 + (lane >> 5)) * ldw + c0 + n0 + (lane & 31);
#pragma unroll
    for (int i = 0; i < 32; ++i) tv[i] = __builtin_nontemporal_load(Wp_ + (size_t)(2 * i) * ldw);
#pragma unroll
    for (int i = 0; i < 32; ++i) scr[(2 * i + (lane >> 5)) * 33 + (lane & 31)] = tv[i];
    LDS_WAIT(); asm volatile("" ::: "memory");
    const int c = lane & 7;
#pragma unroll
    for (int j = 0; j < 4; ++j) { const int n = (lane >> 3) + 8 * j; const LAS float* s = scr + (8 * c) * 33 + n;
        v4u o; o.x = pk2(s[0 * 33], s[1 * 33]); o.y = pk2(s[2 * 33], s[3 * 33]); o.z = pk2(s[4 * 33], s[5 * 33]); o.w = pk2(s[6 * 33], s[7 * 33]);
        *(v4u*)(WT + (size_t)(r0 + n0 + n) * K + k0 + 8 * c) = o; }
    LDS_WAIT(); asm volatile("" ::: "memory");
}

__device__ __forceinline__ void ph_prologue(const Args& a, LAS unsigned char* lds) {
    const int tid = threadIdx.x, lane = tid & 63, wave = tid >> 6;
    unsigned char* ws = a.ws;
    float* MOD = (float*)(ws + WS_MOD);
    for (int j = blockIdx.x; j < 192; j += gridDim.x) {
        LAS float* sc = (LAS float*)lds;
        LAS float* part = (LAS float*)(lds + 9 * 1024 * 4);
        { float cv[18];
#pragma unroll
          for (int i = 0; i < 18; ++i) { const int r = i >> 1, k = ((i & 1) << 9) + tid; cv[i] = r < 8 ? a.in[1][r * 1024 + k] : a.in[3][k]; }
#pragma unroll
          for (int i = 0; i < 18; ++i) sc[tid + 512 * i] = cv[i] / (1.f + expf(-cv[i])); }
        __syncthreads();
        const int kh = lane >> 5, col = lane & 31, n = j * 32 + col;
        float acc[9];
#pragma unroll
        for (int r = 0; r < 9; ++r) acc[r] = 0.f;
        const float* wm = a.in[4] + (size_t)kh * 6144 + n;
        for (int kc = wave * 128; kc < wave * 128 + 128; kc += 64) { float wv[32];
#pragma unroll
            for (int u = 0; u < 32; ++u) wv[u] = __builtin_nontemporal_load(wm + (size_t)(kc + 2 * u) * 6144);
#pragma unroll
            for (int u = 0; u < 32; ++u) {
#pragma unroll
                for (int r = 0; r < 9; ++r) acc[r] += sc[r * 1024 + kc + 2 * u + kh] * wv[u]; } }
#pragma unroll
        for (int r = 0; r < 9; ++r) { acc[r] += __shfl_xor(acc[r], 32); if (kh == 0) part[(wave * 9 + r) * 32 + col] = acc[r]; }
        __syncthreads();
        if (tid < 288) { const int r = tid >> 5, l2 = tid & 31; float s = a.in[5][j * 32 + l2];
#pragma unroll
            for (int w2 = 0; w2 < 8; ++w2) s += part[(w2 * 9 + r) * 32 + l2];
            MOD[r * 6144 + j * 32 + l2] = s; }
        __syncthreads();
    }
    LAS float* scr = (LAS float*)(lds + wave * 16384);
    const int gw = blockIdx.x * 8 + wave, NGW = gridDim.x * 8;
    for (int it = gw; it < 1312; it += NGW) {
        int r = it;
        if (r < 1024) { tr_item(a.in[10], INC, 0, 1024, (bf16*)(ws + WS_WIN), 0, scr, r / 64, r % 64, lane); continue; } r -= 1024;
        if (r < 256) { tr_item(a.in[10], INC, 2064, 1024, (bf16*)(ws + WS_WIN), 2048, scr, r / 16, r % 16, lane); continue; } r -= 256;
        { const int g = r >> 3, q = r & 7; tr_item(a.in[15] + g * 16384, 128, 0, 128, (bf16*)(ws + WS_WP) + g * 16384, 0, scr, q >> 2, q & 3, lane); }
    }
}
__device__ __forceinline__ void late_weights(const Args& a, LAS unsigned char* lds, int gw, int NGW) {
    const int lane = threadIdx.x & 63, wave = threadIdx.x >> 6;
    unsigned char* ws = a.ws;
    LAS float* scr = (LAS float*)(lds + wave * 16384);
    for (int it = gw; it < 4736; it += NGW) {
        int r = it;
        if (r < 512) { tr_item(a.in[17], 1024, 0, 1024, (bf16*)(ws + WS_WOUT), 0, scr, r / 32, r % 32, lane); continue; } r -= 512;
        if (r < 2816) { tr_item(a.in[18], 5632, 0, 1024, (bf16*)(ws + WS_WUP), 0, scr, r / 176, r % 176, lane); continue; } r -= 2816;
        tr_item(a.in[20], 1024, 0, 2816, (bf16*)(ws + WS_WDOWN), 0, scr, r / 32, r % 32, lane);
    }
}

__device__ __forceinline__ void norm1_row(const f32x4 (&A4)[4], const f32x4 (&B4)[4], bf16* XN, bf16* XNC, LAS bf16* hxs, int m, f32x4 (&v)[4], int lane) {
    float s = 0.f;
#pragma unroll
    for (int j = 0; j < 4; ++j) s += (v[j].x * v[j].x + v[j].y * v[j].y) + (v[j].z * v[j].z + v[j].w * v[j].w);
    const float rstd = rsq_f(wave_sum(s) * (1.f / D) + 1e-6f);
    v2u* o8 = (v2u*)(m < MX ? XN + (size_t)m * D : XNC + (size_t)(m - MX) * D) + lane;
#pragma unroll
    for (int j = 0; j < 4; ++j) { v[j] = v[j] * rstd * A4[j] + B4[j];
        v2u o; o.x = pk2(v[j].x, v[j].y); o.y = pk2(v[j].z, v[j].w); o8[64 * j] = o;
        *(LAS v2u*)(hxs + 4 * lane + 256 * j) = o; }
}
__device__ __forceinline__ void norm1_load(const Args& a, int m, f32x4 (&v)[4], int lane) {
    const float* xrow = m < MX ? a.in[0] + (size_t)m * D : a.in[2] + (size_t)(m - MX) * D;
#pragma unroll
    for (int j = 0; j < 4; ++j) v[j] = __builtin_nontemporal_load((const f32x4*)xrow + lane + 64 * j);
}
__device__ __forceinline__ void ph_norm1(const Args& a, LAS unsigned char* lds) {
    const int tid = threadIdx.x, lane = tid & 63, wave = tid >> 6;
    unsigned char* ws = a.ws;
    const float* MOD = (const float*)(ws + WS_MOD);
    float* GATES = (float*)(ws + WS_GATES);
    bf16* XN = (bf16*)(ws + WS_XN); bf16* XNC = (bf16*)(ws + WS_YIN);
    constexpr int WGS = 1032;
    LAS bf16* wgT = (LAS bf16*)lds;
    LAS bf16* hxs = (LAS bf16*)(lds + 16 * WGS * 2) + wave * (4 * WGS);
    { float tv[32]; const float* wsrc = a.in[10] + 2048 + (tid & 15) + (size_t)(tid >> 4) * INC;
#pragma unroll
      for (int i = 0; i < 32; ++i) tv[i] = wsrc[(size_t)(32 * i) * INC];
#pragma unroll
      for (int i = 0; i < 32; ++i) wgT[(tid & 15) * WGS + (tid >> 4) + 32 * i] = (bf16)pk2(tv[i], 0.f); }
    __syncthreads();
    const int r16 = lane & 15, q4 = lane >> 4;
    const int gw = blockIdx.x * 8 + wave, NGW = gridDim.x * 8;
    for (int m0 = gw * 4; m0 < MX; m0 += NGW * 4) {
        f32x4 va[4], vb[4], vc[4], vd[4];
        norm1_load(a, m0, va, lane); norm1_load(a, m0 + 1, vb, lane); norm1_load(a, m0 + 2, vc, lane); norm1_load(a, m0 + 3, vd, lane);
        const int mr = m0 >> 12;
        f32x4 A4[4], B4[4];
#pragma unroll
        for (int j = 0; j < 4; ++j) { const f32x4 g = ((const f32x4*)a.in[6])[lane + 64 * j], sc = ((const f32x4*)(MOD + mr * 6144 + 1024))[lane + 64 * j]; A4[j] = g * (sc + 1.0f); B4[j] = ((const f32x4*)(MOD + mr * 6144))[lane + 64 * j]; }
        norm1_row(A4, B4, XN, XNC, hxs, m0, va, lane);
        norm1_row(A4, B4, XN, XNC, hxs + WGS, m0 + 1, vb, lane);
        norm1_row(A4, B4, XN, XNC, hxs + 2 * WGS, m0 + 2, vc, lane);
        norm1_row(A4, B4, XN, XNC, hxs + 3 * WGS, m0 + 3, vd, lane);
        LDS_WAIT(); asm volatile("" ::: "memory");
        f32x4 acc = (f32x4){0.f, 0.f, 0.f, 0.f};
        const LAS bf16* ap = wgT + r16 * WGS + q4 * 8; const LAS bf16* bp = hxs + (r16 & 3) * WGS + q4 * 8;
#pragma unroll 8
        for (int ks = 0; ks < 32; ++ks) { const bf16x8 av = *(const LAS bf16x8*)(ap + ks * 32); const bf16x8 bv = *(const LAS bf16x8*)(bp + ks * 32); acc = __builtin_amdgcn_mfma_f32_16x16x32_bf16(av, bv, acc, 0, 0, 0); }
        if (r16 < 4) *(f32x4*)(GATES + (size_t)(m0 + r16) * 16 + q4 * 4) = acc;
        LDS_WAIT(); asm volatile("" ::: "memory");
    }
    for (int m = MX + gw; m < MT; m += NGW) {
        f32x4 va[4]; norm1_load(a, m, va, lane);
        f32x4 A4[4], B4[4];
#pragma unroll
        for (int j = 0; j < 4; ++j) { const f32x4 g = ((const f32x4*)a.in[6])[lane + 64 * j], sc = ((const f32x4*)(MOD + 8 * 6144 + 1024))[lane + 64 * j]; A4[j] = g * (sc + 1.0f); B4[j] = ((const f32x4*)(MOD + 8 * 6144))[lane + 64 * j]; }
        norm1_row(A4, B4, XN, XNC, hxs, m, va, lane);
        LDS_WAIT(); asm volatile("" ::: "memory");
        f32x4 acc = (f32x4){0.f, 0.f, 0.f, 0.f};
        const LAS bf16* ap = wgT + r16 * WGS + q4 * 8; const LAS bf16* bp = hxs + q4 * 8;
#pragma unroll 8
        for (int ks = 0; ks < 32; ++ks) { const bf16x8 av = *(const LAS bf16x8*)(ap + ks * 32); const bf16x8 bv = *(const LAS bf16x8*)(bp + ks * 32); acc = __builtin_amdgcn_mfma_f32_16x16x32_bf16(av, bv, acc, 0, 0, 0); }
        if (r16 == 0) *(f32x4*)(GATES + (size_t)m * 16 + q4 * 4) = acc;
        LDS_WAIT(); asm volatile("" ::: "memory");
    }
    __syncthreads();
}

constexpr int SQS = 136;
constexpr int TS = 72;
__device__ __forceinline__ void prep_load(const Args& a, int item, v4u (&ldv)[3][6]) {
    int tl = threadIdx.x; asm volatile("" : "+v"(tl));
    const int cgp = tl & 15, run = tl >> 4, i0 = 2 * run;
    int s, n, h, rowbase, T_;
    if (item < 2048) { h = item & 3; n = (item >> 2) & 63; s = item >> 8; rowbase = s * 4096; T_ = 4096; }
    else { const int r = item - 2048; h = r & 3; n = (r >> 2) & 3; s = r >> 4; rowbase = MX + s * 256; T_ = 256; }
    const bf16* P = (const bf16*)(a.ws + WS_P) + h * 128 + 8 * cgp;
#pragma unroll
    for (int X = 0; X < 3; ++X)
#pragma unroll
        for (int rr = 0; rr < 6; ++rr) { const int t = n * 64 + i0 - 2 + rr; ldv[X][rr] = (v4u){0u, 0u, 0u, 0u};
            if (t >= 0 && t < T_) ldv[X][rr] = __builtin_nontemporal_load((const v4u*)(P + (size_t)X * P_SPLIT + (size_t)(rowbase + t) * 512)); }
}
__device__ __forceinline__ void prep_item(const Args& a, LAS unsigned char* lds, int item, v4u (&ldv)[3][6], int next_item) {
    const int tid = threadIdx.x, lane = tid & 63, wave = tid >> 6;
    unsigned char* ws = a.ws;
    int s, n, h, rowbase, T_;
    const bool isx = item < 2048;
    if (isx) { h = item & 3; n = (item >> 2) & 63; s = item >> 8; rowbase = s * 4096; T_ = 4096; }
    else { const int r = item - 2048; h = r & 3; n = (r >> 2) & 3; s = r >> 4; rowbase = MX + s * 256; T_ = 256; }
    LAS bf16* sQ = (LAS bf16*)lds;
    LAS bf16* sK = (LAS bf16*)(lds + 17408);
    LAS bf16* sKT = (LAS bf16*)(lds + 34816);
    LAS bf16* sVT = (LAS bf16*)(lds + 53248);
    LAS float* Lm = (LAS float*)(lds + 71680);
    LAS float* Tm = (LAS float*)(lds + 108544);
    LAS float* gc = (LAS float*)(lds + 145408);
    LAS float* be = gc + 128;
    LAS float* egc = be + 128;
    const bf16* P = (const bf16*)(ws + WS_P);
    bf16* Qn = (bf16*)(ws + WS_QN) + (size_t)item * 8192;
    bf16* KT = (bf16*)(ws + WS_KT) + (size_t)item * 8192;
    if (gridDim.x & 3) {
        __syncthreads();
        for (int idx = tid; idx < 1920; idx += 512) { const int X = idx / 640, j = (idx / 128) % 5, c = idx & 127; ((LAS float*)(lds + LDS_CW))[idx] = a.in[11][j * 1536 + X * 512 + h * 128 + c]; }
        __syncthreads();
    }
    {
        int tl = tid; asm volatile("" : "+v"(tl));
        const int cgp = tl & 15, run = tl >> 4, i0 = 2 * run;
#pragma unroll
        for (int X = 0; X < 3; ++X) {
            float in[6][8];
#pragma unroll
            for (int rr = 0; rr < 6; ++rr) { const int t = n * 64 + i0 - 2 + rr;
                const v4u u = ldv[X][rr]; (void)t;
                in[rr][0] = bflo(u.x); in[rr][1] = bfhi(u.x); in[rr][2] = bflo(u.y); in[rr][3] = bfhi(u.y); in[rr][4] = bflo(u.z); in[rr][5] = bfhi(u.z); in[rr][6] = bflo(u.w); in[rr][7] = bfhi(u.w); }
            float o0[8], o1[8];
#pragma unroll
            for (int e = 0; e < 8; ++e) { o0[e] = 0.f; o1[e] = 0.f; }
            const LAS float* cw = (const LAS float*)(lds + LDS_CW) + X * 640 + 8 * cgp;
#pragma unroll
            for (int j = 0; j < 5; ++j) { const f32x4 w0 = *(const LAS f32x4*)(cw + j * 128), w1 = *(const LAS f32x4*)(cw + j * 128 + 4);
                const float w[8] = {w0.x, w0.y, w0.z, w0.w, w1.x, w1.y, w1.z, w1.w};
#pragma unroll
                for (int e = 0; e < 8; ++e) { o0[e] += w[e] * in[j][e]; o1[e] += w[e] * in[j + 1][e]; } }
            float s0 = 0.f, s1 = 0.f;
#pragma unroll
            for (int e = 0; e < 8; ++e) { o0[e] = silu_f(o0[e]); o1[e] = silu_f(o1[e]); s0 += o0[e] * o0[e]; s1 += o1[e] * o1[e]; }
            if (X < 2) { s0 = sum16(s0); s1 = sum16(s1);
                float r0 = rsq_f(s0 + 1e-6f), r1 = rsq_f(s1 + 1e-6f);
                if (X == 0) { r0 *= 0.08838834764831845f; r1 *= 0.08838834764831845f; }
#pragma unroll
                for (int e = 0; e < 8; ++e) { o0[e] *= r0; o1[e] *= r1; } }
            if (X < 2) {
                v4u w0, w1; w0.x = pk2(o0[0], o0[1]); w0.y = pk2(o0[2], o0[3]); w0.z = pk2(o0[4], o0[5]); w0.w = pk2(o0[6], o0[7]);
                w1.x = pk2(o1[0], o1[1]); w1.y = pk2(o1[2], o1[3]); w1.z = pk2(o1[4], o1[5]); w1.w = pk2(o1[6], o1[7]);
                LAS bf16* sX = X == 0 ? sQ : sK;
                *(LAS v4u*)(sX + i0 * SQS + 8 * cgp) = w0; *(LAS v4u*)(sX + (i0 + 1) * SQS + 8 * cgp) = w1;
                if (X == 0 && isx) { __builtin_nontemporal_store(w0, (v4u*)(Qn + i0 * 128 + 8 * cgp)); __builtin_nontemporal_store(w1, (v4u*)(Qn + (i0 + 1) * 128 + 8 * cgp)); }
            }
            if (X >= 1) { LAS bf16* sT = X == 1 ? sKT : sVT;
#pragma unroll
                for (int e = 0; e < 8; ++e) { const unsigned pr = pk2(o0[e], o1[e]); *(LAS unsigned*)(sT + (8 * cgp + e) * TS + ((((i0 >> 3) ^ (cgp & 7)) << 3) | (i0 & 7))) = pr; } }
        }
    }
    if (next_item >= 0) prep_load(a, next_item, ldv);
    if (wave < 2) {
        const int d = wave, ip = lane, tok = d ? 63 - ip : ip;
        const float* GATES = (const float*)(ws + WS_GATES) + (size_t)(rowbase + n * 64 + tok) * 16;
        const float ga = GATES[8 + 4 * d + h], gb = GATES[4 * d + h];
        const float A = expf(a.in[12][d * 4 + h]), dtb = a.in[13][d * 4 + h];
        const float xg = ga + dtb;
        const float sp = fmaxf(xg, 0.f) + log1pf(expf(-fabsf(xg)));
        float g = -A * sp;
        const float beta = 1.f / (1.f + expf(-gb));
#pragma unroll
        for (int off = 1; off < 64; off <<= 1) { const float t = __shfl_up(g, off); if (lane >= off) g += t; }
        const float glast = __shfl(g, 63);
        gc[d * 64 + ip] = g; be[d * 64 + ip] = beta; egc[d * 64 + ip] = expf(g);
        const int cidx = item * 2 + d;
        ((float*)(ws + WS_EG))[(size_t)cidx * 64 + ip] = expf(g);
        ((float*)(ws + WS_SD))[(size_t)cidx * 64 + ip] = expf(glast - g);
        if (lane == 63) ((float*)(ws + WS_EGL))[cidx] = expf(g);
    }
    LBAR2();
    {
        int ll = lane; asm volatile("" : "+v"(ll));
        const int r16 = ll & 15, q4 = ll >> 4;
#pragma unroll
        for (int tt = 0; tt < 4; ++tt) {
            const int T = wave * 4 + tt, which = T >> 4, mt = (T >> 2) & 3, nt = T & 3;
            const LAS bf16* sB = sK - which * (64 * SQS);
            f32x4 acc = (f32x4){0.f, 0.f, 0.f, 0.f};
#pragma unroll
            for (int ks = 0; ks < 4; ++ks) { const bf16x8 av = *(const LAS bf16x8*)(sK + (mt * 16 + r16) * SQS + ks * 32 + q4 * 8); const bf16x8 bv = *(const LAS bf16x8*)(sB + (nt * 16 + r16) * SQS + ks * 32 + q4 * 8);
                acc = __builtin_amdgcn_mfma_f32_16x16x32_bf16(av, bv, acc, 0, 0, 0); }
            const int c = nt * 16 + r16, cb = 63 - c, m0 = mt * 16 + q4 * 4;
            if (which == 0) {
#pragma unroll
                for (int j = 0; j < 4; ++j) { const int i = m0 + j, ib = 63 - i; const float v = acc[j];
                    Lm[i * TS + c] = (i > c) ? be[i] * v * __expf(gc[i] - gc[c]) : 0.f;
                    Lm[64 * TS + ib * TS + cb] = (ib > cb) ? be[64 + ib] * v * __expf(gc[64 + ib] - gc[64 + cb]) : 0.f; }
            } else if (isx) {
                float f[4], g[4];
#pragma unroll
                for (int j = 0; j < 4; ++j) { const int jj = m0 + j, jb = 63 - jj; const float v = acc[j];
                    f[j] = (c >= jj) ? v * __expf(gc[c] - gc[jj]) : 0.f;
                    g[j] = (cb >= jb) ? v * __expf(gc[64 + cb] - gc[64 + jb]) : 0.f; }
                LAS bf16* sAT = (LAS bf16*)Tm;
                v2u o; o.x = pk2(f[0], f[1]); o.y = pk2(f[2], f[3]); *(LAS v2u*)(sAT + c * 64 + (((m0 >> 3) ^ (c & 7)) << 3) + (m0 & 4)) = o;
                const int kb = 60 - m0;
                v2u p; p.x = pk2(g[3], g[2]); p.y = pk2(g[1], g[0]); *(LAS v2u*)(sAT + 4096 + cb * 64 + (((kb >> 3) ^ (cb & 7)) << 3) + (kb & 4)) = p;
            }
        }
    }
    LBAR2();
    {
        int tl = tid; asm volatile("" : "+v"(tl));
#pragma unroll
        for (int k = 0; k < 2; ++k) { const int cc = tl + 512 * k, row = cc >> 3, ch = cc & 7;
            { const int ln = cc & 63, krow = (cc >> 7) * 16 + (ln & 15), kch = ((cc >> 6) & 1) * 4 + (ln >> 4);
              __builtin_nontemporal_store(*(const LAS v4u*)(sKT + krow * TS + ((kch ^ ((krow >> 3) & 7)) << 3)), (v4u*)(KT + cc * 8)); }
            if (isx) __builtin_nontemporal_store(*(const LAS v4u*)((const LAS bf16*)Tm + row * 64 + ((ch ^ (row & 7)) << 3)), (v4u*)((bf16*)(ws + WS_AT) + (size_t)(item * 2) * 4096 + cc * 8)); }
    }
    LBAR2();
    if (tid < 128) {
        int tl = tid; asm volatile("" : "+v"(tl));
        const int d = tl >> 6, k = (tl >> 4) & 3, c = tl & 15;
        const LAS float* Lb = Lm + d * (64 * TS) + (16 * k) * TS + 16 * k;
        LAS float* Tb = Tm + d * (64 * TS) + (16 * k) * TS + 16 * k;
        float x[16];
#pragma unroll
        for (int i = 0; i < 16; ++i) x[i] = (i == c) ? 1.f : 0.f;
#pragma unroll
        for (int i = 1; i < 16; ++i) { float acc = 0.f;
#pragma unroll
            for (int j = 0; j < i; ++j) acc += Lb[i * TS + j] * x[j];
            x[i] -= acc; }
#pragma unroll
        for (int i = 0; i < 16; ++i) Tb[i * TS + c] = x[i];
    }
    LBAR2();
    {
        int ll = lane; asm volatile("" : "+v"(ll));
        const int r16 = ll & 15, q4 = ll >> 4;
        const int d = wave >> 2, w = __builtin_amdgcn_readfirstlane(wave & 3);
        const LAS float* Ld = Lm + d * (64 * TS); LAS float* Td = Tm + d * (64 * TS);
        LAS float* tmp = (LAS float*)lds + d * 1920;
#define BLK(P, i, j) ((P) + (16 * (i)) * TS + 16 * (j))
#define TMPB(sl) (tmp + (sl) * 320)
#define MM16(acc, A, lda, B, ldb) do { _Pragma("unroll") for (int ks = 0; ks < 4; ++ks) (acc) = __builtin_amdgcn_mfma_f32_16x16x4f32((A)[r16 * (lda) + 4 * ks + q4], (B)[(4 * ks + q4) * (ldb) + r16], (acc), 0, 0, 0); } while (0)
#define ST16(P, ld, acc, sg) do { _Pragma("unroll") for (int j = 0; j < 4; ++j) (P)[(4 * q4 + j) * (ld) + r16] = (sg) * (acc)[j]; } while (0)
#define LD16(acc, P, ld) do { _Pragma("unroll") for (int j = 0; j < 4; ++j) (acc)[j] = (P)[(4 * q4 + j) * (ld) + r16]; } while (0)
        const f32x4 z4 = (f32x4){0.f, 0.f, 0.f, 0.f};
        f32x4 acc;
        if (w == 0) { acc = z4; MM16(acc, BLK(Ld, 1, 0), TS, BLK(Td, 0, 0), TS); ST16(TMPB(0), 20, acc, 1.f); acc = z4; MM16(acc, BLK(Ld, 3, 0), TS, BLK(Td, 0, 0), TS); ST16(TMPB(2), 20, acc, 1.f); }
        else if (w == 1) { acc = z4; MM16(acc, BLK(Ld, 2, 1), TS, BLK(Td, 1, 1), TS); ST16(TMPB(3), 20, acc, 1.f); acc = z4; MM16(acc, BLK(Ld, 3, 1), TS, BLK(Td, 1, 1), TS); ST16(TMPB(4), 20, acc, 1.f); }
        else if (w == 2) { acc = z4; MM16(acc, BLK(Ld, 3, 2), TS, BLK(Td, 2, 2), TS); ST16(TMPB(5), 20, acc, 1.f); }
        else { acc = z4; MM16(acc, BLK(Ld, 2, 0), TS, BLK(Td, 0, 0), TS); ST16(TMPB(1), 20, acc, 1.f); }
        LBAR2();
        if (w == 0) { acc = z4; MM16(acc, BLK(Td, 1, 1), TS, TMPB(0), 20); ST16(BLK(Td, 1, 0), TS, acc, -1.f); }
        else if (w == 1) { acc = z4; MM16(acc, BLK(Td, 2, 2), TS, TMPB(3), 20); ST16(BLK(Td, 2, 1), TS, acc, -1.f); }
        else if (w == 2) { acc = z4; MM16(acc, BLK(Td, 3, 3), TS, TMPB(5), 20); ST16(BLK(Td, 3, 2), TS, acc, -1.f); }
        LBAR2();
        if (w == 0) { LD16(acc, TMPB(1), 20); MM16(acc, BLK(Ld, 2, 1), TS, BLK(Td, 1, 0), TS); ST16(TMPB(1), 20, acc, 1.f); }
        else if (w == 1) { LD16(acc, TMPB(4), 20); MM16(acc, BLK(Ld, 3, 2), TS, BLK(Td, 2, 1), TS); ST16(TMPB(4), 20, acc, 1.f); }
        else if (w == 2) { LD16(acc, TMPB(2), 20); MM16(acc, BLK(Ld, 3, 1), TS, BLK(Td, 1, 0), TS); ST16(TMPB(2), 20, acc, 1.f); }
        LBAR2();
        if (w == 0) { acc = z4; MM16(acc, BLK(Td, 2, 2), TS, TMPB(1), 20); ST16(BLK(Td, 2, 0), TS, acc, -1.f);
            LDS_WAIT(); asm volatile("" ::: "memory");
            LD16(acc, TMPB(2), 20); MM16(acc, BLK(Ld, 3, 2), TS, BLK(Td, 2, 0), TS); ST16(TMPB(2), 20, acc, 1.f);
            LDS_WAIT(); asm volatile("" ::: "memory");
            acc = z4; MM16(acc, BLK(Td, 3, 3), TS, TMPB(2), 20); ST16(BLK(Td, 3, 0), TS, acc, -1.f); }
        else if (w == 1) { acc = z4; MM16(acc, BLK(Td, 3, 3), TS, TMPB(4), 20); ST16(BLK(Td, 3, 1), TS, acc, -1.f); }
#undef BLK
#undef TMPB
#undef MM16
#undef ST16
#undef LD16
    }
    LBAR2();
    {
        int tl = tid; asm volatile("" : "+v"(tl));
#pragma unroll
        for (int k = 0; k < 2; ++k) { const int gidx = tl + 512 * k, d = gidx >> 9, ip = (gidx >> 3) & 63, j8 = gidx & 7;
            const LAS float* Tr = Tm + d * (64 * TS) + ip * TS + 8 * j8;
            const f32x4 t0 = *(const LAS f32x4*)Tr, t1 = *(const LAS f32x4*)(Tr + 4);
            const f32x4 b0 = *(const LAS f32x4*)(be + d * 64 + 8 * j8), b1 = *(const LAS f32x4*)(be + d * 64 + 8 * j8 + 4);
            const f32x4 e0 = *(const LAS f32x4*)(egc + d * 64 + 8 * j8), e1 = *(const LAS f32x4*)(egc + d * 64 + 8 * j8 + 4);
            const bool up = (8 * j8) > (ip | 15);
            f32x4 u0 = t0 * b0, u1 = t1 * b1; if (up) { u0 = (f32x4){0.f, 0.f, 0.f, 0.f}; u1 = u0; }
            const f32x4 w0 = u0 * e0, w1 = u1 * e1;
            LAS bf16* Tu = (LAS bf16*)(Lm + d * (64 * TS)); LAS bf16* Tw = Tu + 64 * TS;
            v4u ou, ow; int pos;
            if (d) { ou.x = pk2(u1.w, u1.z); ou.y = pk2(u1.y, u1.x); ou.z = pk2(u0.w, u0.z); ou.w = pk2(u0.y, u0.x);
                     ow.x = pk2(w1.w, w1.z); ow.y = pk2(w1.y, w1.x); ow.z = pk2(w0.w, w0.z); ow.w = pk2(w0.y, w0.x); pos = 56 - 8 * j8; }
            else { ou.x = pk2(u0.x, u0.y); ou.y = pk2(u0.z, u0.w); ou.z = pk2(u1.x, u1.y); ou.w = pk2(u1.z, u1.w);
                   ow.x = pk2(w0.x, w0.y); ow.y = pk2(w0.z, w0.w); ow.z = pk2(w1.x, w1.y); ow.w = pk2(w1.z, w1.w); pos = 8 * j8; }
            asm volatile("" ::: "memory");
            *(LAS v4u*)(Tu + ip * TS + pos) = ou; *(LAS v4u*)(Tw + ip * TS + pos) = ow; }
    }
    LBAR2();
    {
        int ll = lane; asm volatile("" : "+v"(ll));
        const int r16 = ll & 15, q4 = ll >> 4;
        const int d = wave >> 2, rt = wave & 3;
        const LAS bf16* Tu = (const LAS bf16*)(Lm + d * (64 * TS)); const LAS bf16* Tw = Tu + 64 * TS;
        LAS bf16* sU = (LAS bf16*)lds + d * 8192;
        LAS bf16* sW = (LAS bf16*)Tm + d * 8192;
        bf16x8 tu[2], tw[2];
#pragma unroll
        for (int ks = 0; ks < 2; ++ks) { tu[ks] = *(const LAS bf16x8*)(Tu + (rt * 16 + r16) * TS + ks * 32 + q4 * 8); tw[ks] = *(const LAS bf16x8*)(Tw + (rt * 16 + r16) * TS + ks * 32 + q4 * 8); }
#pragma unroll
        for (int ct = 0; ct < 8; ++ct) {
            f32x4 au = (f32x4){0.f, 0.f, 0.f, 0.f}, aw = au;
#pragma unroll
            for (int ks = 0; ks < 2; ++ks) { const int swz_ = (((ks * 4 + q4) ^ ((2 * ct + (r16 >> 3)) & 7)) << 3); const bf16x8 vv = *(const LAS bf16x8*)(sVT + (ct * 16 + r16) * TS + swz_); const bf16x8 kv = *(const LAS bf16x8*)(sKT + (ct * 16 + r16) * TS + swz_);
                au = __builtin_amdgcn_mfma_f32_16x16x32_bf16(tu[ks], vv, au, 0, 0, 0);
                aw = __builtin_amdgcn_mfma_f32_16x16x32_bf16(kv, tw[ks], aw, 0, 0, 0); }
            { const int row = ct * 16 + r16, p0 = rt * 16 + q4 * 4;
              v2u o; o.x = pk2(au[0], au[1]); o.y = pk2(au[2], au[3]); *(LAS v2u*)(sU + row * 64 + (((p0 >> 3) ^ (row & 7)) << 3) + (p0 & 4)) = o; }
            { const int row = rt * 16 + r16, p0 = ct * 16 + q4 * 4;
              v2u p; p.x = pk2(aw[0], aw[1]); p.y = pk2(aw[2], aw[3]); *(LAS v2u*)(sW + row * 128 + (((p0 >> 3) ^ (row & 15)) << 3) + (p0 & 4)) = p; }
        }
    }
    LBAR2();
    {
        int tl = tid; asm volatile("" : "+v"(tl));
        bf16* Ut = (bf16*)(ws + WS_UT) + (size_t)(item * 2) * 8192; bf16* Wc = (bf16*)(ws + WS_WC) + (size_t)(item * 2) * 8192;
#pragma unroll
        for (int k = 0; k < 4; ++k) { const int cc = tl + 512 * k;
            { const int row = (cc >> 3) & 127, ch = cc & 7, dd = cc >> 10; const LAS bf16* sUd = (const LAS bf16*)lds + dd * 8192; const int u0 = (cc & 1023) * 2;
              v4u o; { const int un = u0, ln = un & 63, rw = ((un >> 6) & 7) * 16 + (ln & 15), ip = (un >> 9) * 16 + (ln >> 4) * 4; const v2u t = *(const LAS v2u*)(sUd + rw * 64 + (((ip >> 3) ^ (rw & 7)) << 3) + (ip & 4)); o.x = t.x; o.y = t.y; }
              { const int un = u0 + 1, ln = un & 63, rw = ((un >> 6) & 7) * 16 + (ln & 15), ip = (un >> 9) * 16 + (ln >> 4) * 4; const v2u t = *(const LAS v2u*)(sUd + rw * 64 + (((ip >> 3) ^ (rw & 7)) << 3) + (ip & 4)); o.z = t.x; o.w = t.y; }
              __builtin_nontemporal_store(o, (v4u*)(Ut + cc * 8)); }
            { const int f = cc & 1023, ln = f & 63, row = (f >> 8) * 16 + (ln & 15), ch = ((f >> 6) & 3) * 4 + (ln >> 4), dd = cc >> 10;
              __builtin_nontemporal_store(*(const LAS v4u*)((const LAS bf16*)Tm + dd * 8192 + row * 128 + ((ch ^ (row & 15)) << 3)), (v4u*)(Wc + cc * 8)); } }
    }
    LBAR2();
}

__device__ __forceinline__ void pool_item(const Args& a, LAS unsigned char* lds, int it) {
    const int tid = threadIdx.x, lane = tid & 63, wave = tid >> 6;
    unsigned char* ws = a.ws;
    const int r = it & 63, g = (it >> 6) & 3, b = it >> 8;
    const int w = 2 << g, left = w >> 1, right = w - 1 - left;
    const bf16* PP = (const bf16*)(ws + WS_P) + 4 * P_SPLIT + (size_t)b * 4096 * 512 + g * 128;
    LAS float* V = (LAS float*)lds;
    LAS bf16* sD = (LAS bf16*)(lds + 64 * 132 * 4);
    const int rlo = max(0, r - left), rhi = min(63, r + right);
    const float inv_r = 1.f / (float)(rhi - rlo + 1);
    float u[2][8];
#pragma unroll
    for (int k = 0; k < 2; ++k) { const int pr = tid + 512 * k, c = pr >> 4, cgp = pr & 15;
        float acc[8];
#pragma unroll
        for (int e = 0; e < 8; ++e) acc[e] = 0.f;
        v4u qv[16];
#pragma unroll
        for (int rr = 0; rr < 16; ++rr) { const int rp = rlo + rr; qv[rr] = (v4u){0u, 0u, 0u, 0u}; if (rp <= rhi) qv[rr] = *(const v4u*)(PP + (size_t)(rp * 64 + c) * 512 + 8 * cgp); }
#pragma unroll
        for (int rr = 0; rr < 16; ++rr) { const v4u q = qv[rr];
            const float f[8] = {bflo(q.x), bfhi(q.x), bflo(q.y), bfhi(q.y), bflo(q.z), bfhi(q.z), bflo(q.w), bfhi(q.w)};
#pragma unroll
            for (int e = 0; e < 8; ++e) acc[e] += f[e];
            if (rlo + rr == r) {
#pragma unroll
                for (int e = 0; e < 8; ++e) u[k][e] = f[e]; } }
        *(LAS f32x4*)(V + c * 132 + 8 * cgp) = (f32x4){acc[0] * inv_r, acc[1] * inv_r, acc[2] * inv_r, acc[3] * inv_r};
        *(LAS f32x4*)(V + c * 132 + 8 * cgp + 4) = (f32x4){acc[4] * inv_r, acc[5] * inv_r, acc[6] * inv_r, acc[7] * inv_r}; }
    LBAR();
#pragma unroll
    for (int k = 0; k < 2; ++k) { const int pr = tid + 512 * k, c = pr >> 4, cgp = pr & 15;
        const int clo = max(0, c - left), chi = min(63, c + right); const float inv_c = 1.f / (float)(chi - clo + 1);
        f32x4 m0 = (f32x4){0.f, 0.f, 0.f, 0.f}, m1 = m0;
        for (int cp = clo; cp <= chi; ++cp) { m0 += *(const LAS f32x4*)(V + cp * 132 + 8 * cgp); m1 += *(const LAS f32x4*)(V + cp * 132 + 8 * cgp + 4); }
        v4u o; o.x = pk2(m0.x * inv_c - u[k][0], m0.y * inv_c - u[k][1]); o.y = pk2(m0.z * inv_c - u[k][2], m0.w * inv_c - u[k][3]);
        o.z = pk2(m1.x * inv_c - u[k][4], m1.y * inv_c - u[k][5]); o.w = pk2(m1.z * inv_c - u[k][6], m1.w * inv_c - u[k][7]);
        *(LAS v4u*)(sD + c * 136 + 8 * cgp) = o; }
    LBAR();
    {
        const int r16 = lane & 15, q4 = lane >> 4, nt = wave;
        const bf16* Wp = (const bf16*)(ws + WS_WP) + g * 16384;
        bf16x8 bfr[4];
#pragma unroll
        for (int ks = 0; ks < 4; ++ks) bfr[ks] = *(const bf16x8*)(Wp + (nt * 16 + r16) * 128 + ks * 32 + q4 * 8);
        const float psc = a.in[16][g * 128 + nt * 16 + r16];
        LAS bf16* sY = (LAS bf16*)V;
#pragma unroll
        for (int mt = 0; mt < 4; ++mt) { f32x4 acc = (f32x4){0.f, 0.f, 0.f, 0.f};
#pragma unroll
            for (int ks = 0; ks < 4; ++ks) { const bf16x8 av = *(const LAS bf16x8*)(sD + (mt * 16 + r16) * 136 + ks * 32 + q4 * 8); acc = __builtin_amdgcn_mfma_f32_16x16x32_bf16(av, bfr[ks], acc, 0, 0, 0); }
#pragma unroll
            for (int j = 0; j < 4; ++j) sY[(mt * 16 + q4 * 4 + j) * 136 + nt * 16 + r16] = (bf16)pk2(acc[j] * psc, 0.f); }
    }
    LBAR();
    {
        bf16* YIN = (bf16*)(ws + WS_YIN) + (size_t)(b * 4096 + r * 64) * 1024 + 512 + g * 128;
#pragma unroll
        for (int k = 0; k < 2; ++k) { const int cc = tid + 512 * k; *(v4u*)(YIN + (size_t)(cc >> 4) * 1024 + (cc & 15) * 8) = *(const LAS v4u*)((const LAS bf16*)V + (cc >> 4) * 136 + (cc & 15) * 8); }
    }
    LBAR();
}

struct ScanFrag { bf16x8 aW[4], aK[2]; v2u u[2]; f32x4 sd; float egl; };
__device__ __forceinline__ int scan_cidx(int step, int b, int h, int d) {
    int item;
    if (step < 4) { const int n = d ? 3 - step : step; item = 2048 + (b * 4 + n) * 4 + h; }
    else { const int np = step - 4; const int n = d ? 63 - np : np; item = (b * 64 + n) * 4 + h; }
    return item * 2 + d;
}
__device__ __forceinline__ void scan_load(ScanFrag& f, const unsigned char* ws, int step, int b, int h, int d, int sl, int wave, int r16, int q4) {
    step = step < 68 ? step : 67;
    const int mt = wave >> 1, nh = wave & 1;
    const int cidx = scan_cidx(step, b, h, d), item = cidx >> 1;
    const bf16* Wc = (const bf16*)(ws + WS_WC) + (size_t)cidx * 8192;
    const bf16* Ut = (const bf16*)(ws + WS_UT) + (size_t)cidx * 8192;
    const bf16* KT = (const bf16*)(ws + WS_KT) + (size_t)item * 8192;
#pragma unroll
    for (int ks = 0; ks < 4; ++ks) f.aW[ks] = *(const bf16x8*)(Wc + (((mt * 4 + ks) * 64 + q4 * 16 + r16) << 3));
#pragma unroll
    for (int ks = 0; ks < 2; ++ks) f.aK[ks] = *(const bf16x8*)(KT + (((wave * 2 + ks) * 64 + q4 * 16 + r16) << 3));
#pragma unroll
    for (int t = 0; t < 2; ++t) f.u[t] = __builtin_nontemporal_load((const v2u*)(Ut + (((mt * 8 + sl * 4 + 2 * nh + t) * 64 + q4 * 16 + r16) << 2)));
    f.sd = *(const f32x4*)((const float*)(ws + WS_SD) + (size_t)cidx * 64 + mt * 16 + q4 * 4);
    f.egl = ((const float*)(ws + WS_EGL))[cidx];
}
template <bool IS_X>
__device__ __forceinline__ void scan_step(const ScanFrag& f, f32x4 (&accS)[4], unsigned char* ws, float* sn_base, int step, int b, int h, int d, int sl, int wave, int r16, int q4, LAS bf16* St, LAS bf16* Vt2) {
    LAS bf16* Vt = Vt2 + 64 * 72;
    const int mt = wave >> 1, nh = wave & 1, ip = mt * 16 + q4 * 4;
    const int cidx = scan_cidx(step, b, h, d);
#pragma unroll
    for (int t = 0; t < 2; ++t) {
        const int ncol = (2 * nh + t) * 16 + r16;
        f32x4 acc1 = (f32x4){0.f, 0.f, 0.f, 0.f};
#pragma unroll
        for (int ks = 0; ks < 4; ++ks) { const bf16x8 sb = *(const LAS bf16x8*)(St + ncol * 136 + ks * 32 + q4 * 8); acc1 = __builtin_amdgcn_mfma_f32_16x16x32_bf16(f.aW[ks], sb, acc1, 0, 0, 0); }
        const float v0 = bflo(f.u[t].x) - acc1[0], v1 = bfhi(f.u[t].x) - acc1[1], v2 = bflo(f.u[t].y) - acc1[2], v3 = bfhi(f.u[t].y) - acc1[3];
        if (IS_X) { v2u o; o.x = pk2(v0, v1); o.y = pk2(v2, v3); *(LAS v2u*)(Vt + ncol * 72 + ip) = o; }
        const float s0 = v0 * f.sd.x, s1 = v1 * f.sd.y, s2 = v2 * f.sd.z, s3 = v3 * f.sd.w;
        v2u o2;
        if (d) { o2.x = pk2(s3, s2); o2.y = pk2(s1, s0); *(LAS v2u*)(Vt2 + ncol * 72 + 60 - ip) = o2; }
        else { o2.x = pk2(s0, s1); o2.y = pk2(s2, s3); *(LAS v2u*)(Vt2 + ncol * 72 + ip) = o2; }
    }
    if (IS_X) { bf16* SN = (bf16*)sn_base + (size_t)cidx * 16384 + (size_t)sl * 8192;
        const int tid_ = wave * 64 + q4 * 16 + r16;
#pragma unroll
        for (int k = 0; k < 2; ++k) { const int c = tid_ + 512 * k, ln = c & 63, row = (c >> 8) * 16 + (ln & 15), ch = ((c >> 6) & 3) * 4 + (ln >> 4);
            __builtin_nontemporal_store(*(const LAS v4u*)(St + row * 136 + ch * 8), (v4u*)(SN + c * 8)); } }
    LBAR2();
    if (IS_X) { const int tid_ = wave * 64 + q4 * 16 + r16;
        const int ln = tid_ & 63, row = (tid_ >> 7) * 16 + (ln & 15), ch = ((tid_ >> 6) & 1) * 4 + (ln >> 4);
        __builtin_nontemporal_store(*(const LAS v4u*)(Vt + row * 72 + ch * 8), (v4u*)((bf16*)(ws + WS_OF) + (size_t)cidx * 8192 + (size_t)sl * 4096 + tid_ * 8)); }
#pragma unroll
    for (int n2 = 0; n2 < 4; ++n2) { accS[n2] = accS[n2] * f.egl;
#pragma unroll
        for (int ks = 0; ks < 2; ++ks) { const bf16x8 vb = *(const LAS bf16x8*)(Vt2 + (n2 * 16 + r16) * 72 + ks * 32 + q4 * 8); accS[n2] = __builtin_amdgcn_mfma_f32_16x16x32_bf16(f.aK[ks], vb, accS[n2], 0, 0, 0); }
        v2u o; o.x = pk2(accS[n2][0], accS[n2][1]); o.y = pk2(accS[n2][2], accS[n2][3]);
        *(LAS v2u*)(St + (n2 * 16 + r16) * 136 + wave * 16 + q4 * 4) = o; }
    LBAR2();
}

template <int MODE>
__device__ __forceinline__ void ph_scan(const Args& a, LAS unsigned char* lds, int nblk) {
    const int tid = threadIdx.x, lane = tid & 63, wave = tid >> 6, r16 = lane & 15, q4 = lane >> 4;
    unsigned char* ws = a.ws;
    LAS bf16* St = (LAS bf16*)lds;
    LAS bf16* Vt2 = St + 64 * 136;
    for (int wi = blockIdx.x; wi < 128; wi += nblk) {
        const int xcd = wi & 7, jq = wi >> 3; const int stream = xcd * 8 + (jq >> 1), sl = jq & 1;
        const int b = stream >> 3, h = (stream >> 1) & 3, d = stream & 1;
        for (int i = tid; i < 64 * 136 / 2; i += 512) ((LAS unsigned*)St)[i] = 0u;
        f32x4 accS[4];
#pragma unroll
        for (int n2 = 0; n2 < 4; ++n2) accS[n2] = (f32x4){0.f, 0.f, 0.f, 0.f};
        ScanFrag f0, f1, f2, f3;
        scan_load(f0, ws, 0, b, h, d, sl, wave, r16, q4);
        scan_load(f1, ws, 1, b, h, d, sl, wave, r16, q4);
        scan_load(f2, ws, 2, b, h, d, sl, wave, r16, q4);
        __syncthreads();
        {
            scan_load(f3, ws, 3, b, h, d, sl, wave, r16, q4); scan_step<false>(f0, accS, ws, a.out, 0, b, h, d, sl, wave, r16, q4, St, Vt2);
            scan_load(f0, ws, 4, b, h, d, sl, wave, r16, q4); scan_step<false>(f1, accS, ws, a.out, 1, b, h, d, sl, wave, r16, q4, St, Vt2);
            scan_load(f1, ws, 5, b, h, d, sl, wave, r16, q4); scan_step<false>(f2, accS, ws, a.out, 2, b, h, d, sl, wave, r16, q4, St, Vt2);
            scan_load(f2, ws, 6, b, h, d, sl, wave, r16, q4); scan_step<false>(f3, accS, ws, a.out, 3, b, h, d, sl, wave, r16, q4, St, Vt2);
        }
        for (int s4 = 4; s4 < 68; s4 += 4) {
            if (MODE != 2) scan_load(f3, ws, s4 + 3, b, h, d, sl, wave, r16, q4); scan_step<MODE == 0>(f0, accS, ws, a.out, s4, b, h, d, sl, wave, r16, q4, St, Vt2);
            if (MODE != 2) scan_load(f0, ws, s4 + 4, b, h, d, sl, wave, r16, q4); scan_step<MODE == 0>(f1, accS, ws, a.out, s4 + 1, b, h, d, sl, wave, r16, q4, St, Vt2);
            if (MODE != 2) scan_load(f1, ws, s4 + 5, b, h, d, sl, wave, r16, q4); scan_step<MODE == 0>(f2, accS, ws, a.out, s4 + 2, b, h, d, sl, wave, r16, q4, St, Vt2);
            if (MODE != 2) scan_load(f2, ws, s4 + 6, b, h, d, sl, wave, r16, q4); scan_step<MODE == 0>(f3, accS, ws, a.out, s4 + 3, b, h, d, sl, wave, r16, q4, St, Vt2);
        }
        asm volatile("s_waitcnt vmcnt(0)" ::: "memory");
        __syncthreads();
    }
}

constexpr int OUT_GRP = 73728;
__device__ __forceinline__ void out_pair(const Args& a, LAS unsigned char* lds0, int pair) {
    const int tid = threadIdx.x, lane = tid & 63, wave = tid >> 6, r16 = lane & 15, q4 = lane >> 4;
    const int grp = wave >> 2, wq = wave & 3, gt = tid & 255;
    unsigned char* ws = a.ws;
    const int item = pair * 2 + grp;
    const int h = item & 3, n = (item >> 2) & 63, b = item >> 8;
    LAS unsigned char* lds = lds0 + grp * OUT_GRP;
    LAS bf16* sQ = (LAS bf16*)lds;
    LAS bf16* sA = (LAS bf16*)(lds + 17408);
    LAS bf16* sZ = (LAS bf16*)(lds + 35840);
    LAS float* red = (LAS float*)(lds + 53248);
    LAS float* rinv = red + 256;
    LAS float* sEG = rinv + 64;
    const size_t trow = (size_t)b * 4096 + n * 64;
    v4u stq[4], sta[4], stz[4];
    {
        const bf16* Qn = (const bf16*)(ws + WS_QN) + (size_t)item * 8192;
        const bf16* AT = (const bf16*)(ws + WS_AT) + (size_t)(item * 2) * 4096;
        const bf16* PZ = (const bf16*)(ws + WS_P) + 3 * P_SPLIT + trow * 512 + h * 128;
#pragma unroll
        for (int k = 0; k < 4; ++k) { const int c = gt + 256 * k; stq[k] = __builtin_nontemporal_load((const v4u*)(Qn + c * 8)); sta[k] = __builtin_nontemporal_load((const v4u*)(AT + c * 8)); stz[k] = __builtin_nontemporal_load((const v4u*)(PZ + (size_t)(c >> 4) * 512 + (c & 15) * 8)); }
    }
    bf16x8 sb[2][2][4], vb[2][2][2];
#define OUT_LOAD_FRAGS(d) do { _Pragma("unroll") for (int t = 0; t < 2; ++t) { \
            const int cidx = item * 2 + (d), nt = 2 * wq + t; \
            const bf16* SN = (const bf16*)a.out + (size_t)cidx * 16384 + (((nt * 4) * 64 + q4 * 16 + r16) << 3); \
            const bf16* VN = (const bf16*)(ws + WS_OF) + (size_t)cidx * 8192 + (((nt * 2) * 64 + q4 * 16 + r16) << 3); \
            _Pragma("unroll") for (int ks = 0; ks < 4; ++ks) sb[d][t][ks] = __builtin_nontemporal_load((const bf16x8*)(SN + ks * 512)); \
            _Pragma("unroll") for (int ks = 0; ks < 2; ++ks) vb[d][t][ks] = __builtin_nontemporal_load((const bf16x8*)(VN + ks * 512)); } } while (0)
    OUT_LOAD_FRAGS(0);
    float egv = 0.f;
    if (gt < 128) egv = ((const float*)(ws + WS_EG))[(size_t)(item * 2) * 64 + gt];
    {
#pragma unroll
        for (int k = 0; k < 4; ++k) { const int c = gt + 256 * k;
            *(LAS v4u*)(sQ + (c >> 4) * 136 + (c & 15) * 8) = stq[k];
            *(LAS v4u*)(sA + (c >> 3) * 72 + (c & 7) * 8) = sta[k];
            *(LAS v4u*)(sZ + (c >> 4) * 136 + (c & 15) * 8) = stz[k]; }
        if (gt < 128) sEG[gt] = egv;
    }
    asm volatile("" ::: "memory");
    OUT_LOAD_FRAGS(1);
#undef OUT_LOAD_FRAGS
    __syncthreads();
    f32x4 o[2][4];
#pragma unroll
    for (int t = 0; t < 2; ++t)
#pragma unroll
        for (int mt = 0; mt < 4; ++mt) o[t][mt] = (f32x4){0.f, 0.f, 0.f, 0.f};
#pragma unroll
    for (int d = 0; d < 2; ++d) {
#pragma unroll
        for (int mt = 0; mt < 4; ++mt) {
            bf16x8 qa[4], aa[2];
#pragma unroll
            for (int ks = 0; ks < 4; ++ks) qa[ks] = *(const LAS bf16x8*)(sQ + (mt * 16 + r16) * 136 + ks * 32 + q4 * 8);
            const int arow = d ? 63 - (mt * 16 + r16) : (mt * 16 + r16);
#pragma unroll
            for (int ks = 0; ks < 2; ++ks) aa[ks] = *(const LAS bf16x8*)(sA + (d * 64 + arow) * 72 + ks * 32 + q4 * 8);
            const int t0 = mt * 16 + q4 * 4;
            f32x4 eg;
            if (d) { const f32x4 e = *(const LAS f32x4*)(sEG + 64 + 60 - t0); eg = (f32x4){e.w, e.z, e.y, e.x}; } else eg = *(const LAS f32x4*)(sEG + t0);
#pragma unroll
            for (int t = 0; t < 2; ++t) {
                f32x4 aq = (f32x4){0.f, 0.f, 0.f, 0.f};
#pragma unroll
                for (int ks = 0; ks < 4; ++ks) aq = __builtin_amdgcn_mfma_f32_16x16x32_bf16(qa[ks], sb[d][t][ks], aq, 0, 0, 0);
                f32x4 acc = aq * eg;
#pragma unroll
                for (int ks = 0; ks < 2; ++ks) acc = __builtin_amdgcn_mfma_f32_16x16x32_bf16(aa[ks], vb[d][t][ks], acc, 0, 0, 0);
                o[t][mt] += acc;
            }
            asm volatile("" ::: "memory");
        }
    }
#pragma unroll
    for (int mt = 0; mt < 4; ++mt)
#pragma unroll
        for (int j = 0; j < 4; ++j) { float p = o[0][mt][j] * o[0][mt][j] + o[1][mt][j] * o[1][mt][j]; p = sum16(p); if (r16 == 0) red[wq * 64 + mt * 16 + q4 * 4 + j] = p; }
    __syncthreads();
    if (gt < 64) { const float t = (red[gt] + red[64 + gt]) + (red[128 + gt] + red[192 + gt]); rinv[gt] = rsq_f(t * (1.f / 128.f) + 1e-6f); }
    __syncthreads();
#pragma unroll
    for (int t = 0; t < 2; ++t) {
        const int v = (2 * wq + t) * 16 + r16; const float onw = a.in[14][v];
#pragma unroll
        for (int mt = 0; mt < 4; ++mt)
#pragma unroll
            for (int j = 0; j < 4; ++j) { const int tk = mt * 16 + q4 * 4 + j; const float z = bf2f(sZ[tk * 136 + v]);
                sQ[tk * 136 + v] = (bf16)pk2(o[t][mt][j] * rinv[tk] * onw * silu_f(z), 0.f); }
    }
    __syncthreads();
    {
        bf16* YIN = (bf16*)(ws + WS_YIN) + trow * 1024 + h * 128;
#pragma unroll
        for (int k = 0; k < 4; ++k) { const int c = gt + 256 * k; *(v4u*)(YIN + (size_t)(c >> 4) * 1024 + (c & 15) * 8) = *(const LAS v4u*)(sQ + (c >> 4) * 136 + (c & 15) * 8); }
    }
    __syncthreads();
}

__device__ __forceinline__ void ph_mid(const Args& a) {
    const int tid = threadIdx.x, lane = tid & 63, wave = tid >> 6;
    unsigned char* ws = a.ws;
    const float* MOD = (const float*)(ws + WS_MOD);
    const bf16* YX = (const bf16*)(ws + WS_YX);
    bf16* XN2 = (bf16*)(ws + WS_XN);
    const int gw = blockIdx.x * 8 + wave, NGW = gridDim.x * 8;
    constexpr int R = 2;
    for (int t0 = gw * R; t0 < MX; t0 += NGW * R) {
        const int b = t0 >> 12;
        f32x4 xv[R][4]; v2u yv[R][4];
#pragma unroll
        for (int r = 0; r < R; ++r)
#pragma unroll
            for (int j = 0; j < 4; ++j) { xv[r][j] = __builtin_nontemporal_load((const f32x4*)(a.in[0] + (size_t)(t0 + r) * D) + lane + 64 * j); yv[r][j] = __builtin_nontemporal_load((const v2u*)(YX + (size_t)(t0 + r) * D) + lane + 64 * j); }
        f32x4 G1[4], GT[4], A2[4], B2[4];
#pragma unroll
        for (int j = 0; j < 4; ++j) { G1[j] = ((const f32x4*)a.in[7])[lane + 64 * j]; GT[j] = ((const f32x4*)(MOD + b * 6144 + 2048))[lane + 64 * j];
            const f32x4 g = ((const f32x4*)a.in[8])[lane + 64 * j], sc = ((const f32x4*)(MOD + b * 6144 + 4096))[lane + 64 * j]; A2[j] = g * (sc + 1.0f); B2[j] = ((const f32x4*)(MOD + b * 6144 + 3072))[lane + 64 * j]; }
#pragma unroll
        for (int r = 0; r < R; ++r) {
            const int t = t0 + r;
            f32x4 y[4]; float s = 0.f;
#pragma unroll
            for (int j = 0; j < 4; ++j) { const v2u q = yv[r][j]; y[j] = (f32x4){bflo(q.x), bfhi(q.x), bflo(q.y), bfhi(q.y)}; s += (y[j].x * y[j].x + y[j].y * y[j].y) + (y[j].z * y[j].z + y[j].w * y[j].w); }
            const float r1 = rsq_f(wave_sum(s) * (1.f / D) + 1e-6f);
            f32x4 x1[4]; float s2 = 0.f;
            v2u* orow = (v2u*)((bf16*)(ws + WS_X1) + (size_t)t * D) + lane;
#pragma unroll
            for (int j = 0; j < 4; ++j) { x1[j] = xv[r][j] + GT[j] * (y[j] * r1 * G1[j]); { v2u ob; ob.x = pk2(x1[j].x, x1[j].y); ob.y = pk2(x1[j].z, x1[j].w); __builtin_nontemporal_store(ob, orow + 64 * j); }
                s2 += (x1[j].x * x1[j].x + x1[j].y * x1[j].y) + (x1[j].z * x1[j].z + x1[j].w * x1[j].w); }
            const float r2 = rsq_f(wave_sum(s2) * (1.f / D) + 1e-6f);
            v2u* o8 = (v2u*)(XN2 + (size_t)t * D) + lane;
#pragma unroll
            for (int j = 0; j < 4; ++j) { const f32x4 hv = x1[j] * r2 * A2[j] + B2[j]; v2u o; o.x = pk2(hv.x, hv.y); o.y = pk2(hv.z, hv.w); o8[64 * j] = o; }
        }
    }
}

template <int NCG>
__device__ __forceinline__ void ph_act(const Args& a) {
    unsigned char* ws = a.ws;
    const bf16* G = (const bf16*)(ws + WS_G); bf16* U = (bf16*)(ws + WS_U);
    const int gt = blockIdx.x * 512 + threadIdx.x, NT = gridDim.x * 512;
    constexpr int RUN = 8;
    for (int it = gt; it < (MX / RUN) * NCG; it += NT) {
        const int cgp = it % NCG, run = it / NCG, t0 = run * RUN;
        const bf16* gp = G + (size_t)t0 * DFF + 8 * cgp; bf16* up = U + (size_t)t0 * DFF + 8 * cgp;
        v4u gv[RUN + 2], uv[RUN];
        gv[0] = (v4u){0u, 0u, 0u, 0u}; gv[RUN + 1] = (v4u){0u, 0u, 0u, 0u};
        if ((t0 & 4095) != 0) gv[0] = *(const v4u*)(gp - DFF);
        if (((t0 + RUN) & 4095) != 0) gv[RUN + 1] = *(const v4u*)(gp + (size_t)RUN * DFF);
#pragma unroll
        for (int i = 0; i < RUN; ++i) { gv[i + 1] = *(const v4u*)(gp + (size_t)i * DFF); uv[i] = *(const v4u*)(up + (size_t)i * DFF); }
        const float* cw = a.in[19] + 8 * cgp;
        float w[3][8];
#pragma unroll
        for (int j = 0; j < 3; ++j) { const f32x4 w0 = *(const f32x4*)(cw + j * DFF), w1 = *(const f32x4*)(cw + j * DFF + 4); w[j][0] = w0.x; w[j][1] = w0.y; w[j][2] = w0.z; w[j][3] = w0.w; w[j][4] = w1.x; w[j][5] = w1.y; w[j][6] = w1.z; w[j][7] = w1.w; }
#pragma unroll
        for (int i = 0; i < RUN; ++i) {
            const v4u prev = gv[i], curv = gv[i + 1], nx = gv[i + 2], uu = uv[i];
            const float p[8] = {bflo(prev.x), bfhi(prev.x), bflo(prev.y), bfhi(prev.y), bflo(prev.z), bfhi(prev.z), bflo(prev.w), bfhi(prev.w)};
            const float c[8] = {bflo(curv.x), bfhi(curv.x), bflo(curv.y), bfhi(curv.y), bflo(curv.z), bfhi(curv.z), bflo(curv.w), bfhi(curv.w)};
            const float q[8] = {bflo(nx.x), bfhi(nx.x), bflo(nx.y), bfhi(nx.y), bflo(nx.z), bfhi(nx.z), bflo(nx.w), bfhi(nx.w)};
            const float uf[8] = {bflo(uu.x), bfhi(uu.x), bflo(uu.y), bfhi(uu.y), bflo(uu.z), bfhi(uu.z), bflo(uu.w), bfhi(uu.w)};
            float r[8];
#pragma unroll
            for (int e = 0; e < 8; ++e) r[e] = silu_f(w[0][e] * p[e] + w[1][e] * c[e] + w[2][e] * q[e]) * uf[e];
            v4u o; o.x = pk2(r[0], r[1]); o.y = pk2(r[2], r[3]); o.z = pk2(r[4], r[5]); o.w = pk2(r[6], r[7]);
            *(v4u*)(up + (size_t)i * DFF) = o;
        }
    }
}

__device__ __forceinline__ void ph_final(const Args& a) {
    const int tid = threadIdx.x, lane = tid & 63, wave = tid >> 6;
    unsigned char* ws = a.ws;
    const float* MOD = (const float*)(ws + WS_MOD);
    const bf16* Y2 = (const bf16*)(ws + WS_Y2);
    const int gw = blockIdx.x * 8 + wave, NGW = gridDim.x * 8;
    constexpr int R = 4;
    for (int t0 = gw * R; t0 < MX; t0 += NGW * R) {
        const int b = t0 >> 12;
        f32x4 xv[R][4]; v2u yv[R][4];
#pragma unroll
        for (int r = 0; r < R; ++r)
#pragma unroll
            for (int j = 0; j < 4; ++j) { const v2u xb = __builtin_nontemporal_load((const v2u*)((const bf16*)(ws + WS_X1) + (size_t)(t0 + r) * D) + lane + 64 * j); xv[r][j] = (f32x4){bflo(xb.x), bfhi(xb.x), bflo(xb.y), bfhi(xb.y)}; yv[r][j] = __builtin_nontemporal_load((const v2u*)(Y2 + (size_t)(t0 + r) * D) + lane + 64 * j); }
        f32x4 GG[4];
#pragma unroll
        for (int j = 0; j < 4; ++j) GG[j] = ((const f32x4*)a.in[9])[lane + 64 * j] * ((const f32x4*)(MOD + b * 6144 + 5120))[lane + 64 * j];
#pragma unroll
        for (int r = 0; r < R; ++r) {
            f32x4 y[4]; float s = 0.f;
#pragma unroll
            for (int j = 0; j < 4; ++j) { const v2u q = yv[r][j]; y[j] = (f32x4){bflo(q.x), bfhi(q.x), bflo(q.y), bfhi(q.y)}; s += (y[j].x * y[j].x + y[j].y * y[j].y) + (y[j].z * y[j].z + y[j].w * y[j].w); }
            const float r1 = rsq_f(wave_sum(s) * (1.f / D) + 1e-6f);
            f32x4* orow = (f32x4*)(a.out + (size_t)(t0 + r) * D) + lane;
#pragma unroll
            for (int j = 0; j < 4; ++j) __builtin_nontemporal_store(xv[r][j] + GG[j] * (y[j] * r1), orow + 64 * j);
        }
    }
}

typedef GAS unsigned gu32;
#define XB_TMO      128
#define XB_XCNT(j)  (256  + 64 * (j))
#define XB_XSUB(j)  (1280 + 64 * (j))
#define XB_XGEN(j)  (2304 + 64 * (j))
#define XB_TOP      3328
#define XB_TOPGEN   3392
#define XCD_BAR_WORDS 3456
#define XB_SPIN_CAP (1u << 18)

__device__ __forceinline__ unsigned xb_ld(unsigned* p)              { return __hip_atomic_load(p, __ATOMIC_RELAXED, __HIP_MEMORY_SCOPE_AGENT); }
__device__ __forceinline__ unsigned xb_add(unsigned* p, unsigned v) { return __hip_atomic_fetch_add(p, v, __ATOMIC_RELAXED, __HIP_MEMORY_SCOPE_AGENT); }
__device__ __forceinline__ unsigned xb_xcc_id() { return (unsigned)__builtin_amdgcn_s_getreg((3 << 11) | 20) & 0xFu; }
#define XB_SPIN(cond, bar) do { unsigned _sp = 0; while (cond) { __builtin_amdgcn_s_sleep(1); \
    if ((++_sp & 255u) == 0u) { if (xb_ld(&(bar)[XB_TMO])) break; if (_sp > XB_SPIN_CAP) { atomicAdd(&(bar)[XB_TMO], 1u); break; } } } } while (0)

struct XcdBarrier {
    unsigned* bar; unsigned x;
    volatile LAS unsigned* st;
};

__device__ __forceinline__ XcdBarrier xcd_barrier_post(unsigned* bar, volatile LAS unsigned* st) {
    XcdBarrier b; b.bar = bar; b.x = xb_xcc_id(); b.st = st;
    if (threadIdx.x == 0) (void)xb_add(&bar[XB_XCNT(b.x)], 1u);
    return b;
}
__device__ __forceinline__ void xcd_barrier_complete(unsigned* bar, unsigned x, unsigned& nloc, unsigned& nx) {
    const unsigned G = gridDim.x * gridDim.y * gridDim.z;
    unsigned sum, cnt, mine, sp = 0u;
    for (;;) {
        sum = 0u; cnt = 0u; mine = 0u;
#pragma unroll
        for (unsigned j = 0; j < 16; ++j) { const unsigned c = xb_ld(&bar[XB_XCNT(j)]); sum += c; cnt += (c > 0u) ? 1u : 0u; mine = (j == x) ? c : mine; }
        if (sum == G) break;
        __builtin_amdgcn_s_sleep(1);
        if ((++sp & 255u) == 0u) { if (xb_ld(&bar[XB_TMO])) break; if (sp > XB_SPIN_CAP) { atomicAdd(&bar[XB_TMO], 1u); break; } }
    }
    nloc = mine > 0u ? mine : 1u; nx = cnt > 0u ? cnt : 1u;
}

__device__ __forceinline__ void xcd_barrier(const XcdBarrier& b) {
    asm volatile("s_waitcnt vmcnt(0)" ::: "memory");
    __syncthreads();
    if (threadIdx.x == 0) {
        unsigned* bar = b.bar;
        __builtin_amdgcn_s_waitcnt(0);
        unsigned nloc = b.st[0], nx = b.st[1];
        if (nloc == 0u) { xcd_barrier_complete(bar, b.x, nloc, nx); b.st[0] = nloc; b.st[1] = nx; }
        const unsigned old = xb_add(&bar[XB_XSUB(b.x)], 1u);
        const unsigned gen = old / nloc;
        if (old + 1u == (gen + 1u) * nloc) {
            __builtin_amdgcn_fence(__ATOMIC_RELEASE, "agent");
            asm volatile("s_waitcnt vmcnt(0)" ::: "memory");
            const unsigned og = xb_add(&bar[XB_TOP], 1u);
            const unsigned tg = og / nx;
            if (og + 1u == (tg + 1u) * nx) xb_add(&bar[XB_TOPGEN], 1u);
            else XB_SPIN(xb_ld(&bar[XB_TOPGEN]) == tg, bar);
            __builtin_amdgcn_fence(__ATOMIC_ACQUIRE, "agent");
            xb_add(&bar[XB_XGEN(b.x)], 1u);
            asm volatile("s_waitcnt vmcnt(0)" ::: "memory");
        } else {
            XB_SPIN(xb_ld(&bar[XB_XGEN(b.x)]) == gen, bar);
            __builtin_amdgcn_fence(__ATOMIC_ACQUIRE, "agent");
            asm volatile("s_waitcnt vmcnt(0)" ::: "memory");
        }
    }
    __syncthreads();
}

constexpr int NPH = 12;
__global__ void __launch_bounds__(512, 2) mega_fwd(Args a) {
    extern __shared__ __attribute__((aligned(16))) unsigned char lds_raw[];
    LAS unsigned char* lds = (LAS unsigned char*)lds_raw;
    cg::grid_group grid = cg::this_grid();
    unsigned char* ws = a.ws;
    if (threadIdx.x < 64) ((LAS unsigned*)(lds + LDS_CTL))[threadIdx.x] = 0u;
    __syncthreads();
    XcdBarrier bar = xcd_barrier_post((unsigned*)ws, (volatile LAS unsigned*)(lds + LDS_CTL + 64));
    const int lo = a.ph_lo, hi = a.ph_hi;
#ifndef PHMASK
#define PHMASK 0xFFF
#endif
#define IN(k) (((PHMASK >> (k)) & 1) && lo <= (k) && (k) < hi)
#ifndef DUP_MASK
#define DUP_MASK 0
#endif
#define REP(k) for (int rep_ = 0; rep_ < ((((DUP_MASK) >> (k)) & 1) ? 2 : 1); ++rep_)
#define REPBAR() do { if (rep_) xcd_barrier(bar); } while (0)
#define SEAM(k) do { if (IN(k) && IN((k) + 1)) xcd_barrier(bar); } while (0)
    if (a.ph_lo < 0) grid.sync();
    if (IN(0)) REP(0) { REPBAR(); ph_prologue(a, lds); }
    SEAM(0);
    if (IN(1)) REP(1) { REPBAR(); ph_norm1(a, lds); }
    SEAM(1);
    if (IN(2)) REP(2) {   REPBAR();
        pg8::Gemm g{(const bf16*)(ws + WS_XN), (const bf16*)(ws + WS_WIN), MX, 2560, 1024}; pg8::StaticOrder S; S.init(MX, 2560, (int)gridDim.x, (int)blockIdx.x);
        pg8::EpiBf16<0> E{(bf16*)(ws + WS_P), 512, nullptr, 512, P_SPLIT, 1.f};
        pg8::gemm_phase<pg8::EpiBf16<0>, pg8::StaticOrder, true, true>(lds, g, S, E);
    }
    SEAM(2);
    if (IN(3)) REP(3) { REPBAR();
#ifndef P3_PREP_REPS
#define P3_PREP_REPS 1
#endif
#ifndef P3_POOL_REPS
#define P3_POOL_REPS 1
#endif
        unsigned* cflag = (unsigned*)ws + 3600;
        const int G = (int)gridDim.x, bid = (int)blockIdx.x;
        const bool cw_lds = (G & 3) == 0;
        if (cw_lds) { for (int idx = threadIdx.x; idx < 1920; idx += 512) { const int X = idx / 640, j = (idx / 128) % 5, c = idx & 127; ((LAS float*)(lds + LDS_CW))[idx] = a.in[11][j * 1536 + X * 512 + (bid & 3) * 128 + c]; } __syncthreads(); }
        if (G >= 160) {
            if (bid < 32) {
                pg8::Gemm g{(const bf16*)(ws + WS_YIN), (const bf16*)(ws + WS_WIN) + (size_t)512 * 1024, MC, 1024, 1024}; pg8::StaticOrder S; S.init(MC, 1024, 32, bid);
                pg8::EpiBf16<0> E{(bf16*)(ws + WS_P) + P_SPLIT + (size_t)MX * 512, 512, nullptr, 512, P_SPLIT, 1.f};
                pg8::gemm_phase<pg8::EpiBf16<0>, pg8::StaticOrder, true, true>(lds, g, S, E);
                __threadfence(); __syncthreads();
                if (threadIdx.x == 0) __hip_atomic_fetch_add(cflag, 1u, __ATOMIC_RELEASE, __HIP_MEMORY_SCOPE_AGENT);
            }
            {
              const bool rebal = (G == 256);
              const int xlim = (rebal && bid < 32) ? 1792 : 2048;
              const int extra = (rebal && bid >= 160 && bid < 192) ? 1792 + (bid - 160) : -1;
              v4u ldv[3][6]; prep_load(a, bid, ldv);
              for (int it = bid; it < xlim; it += G) prep_item(a, lds, it, ldv, it + G < xlim ? it + G : extra);
              if (extra >= 0) prep_item(a, lds, extra, ldv, -1); }
            for (int it = bid - 32; it >= 0 && it < 128; it += G) {
                if (threadIdx.x == 0) { unsigned sp = 0; while (__hip_atomic_load(cflag, __ATOMIC_RELAXED, __HIP_MEMORY_SCOPE_AGENT) < 32u && ++sp < (1u << 22)) __builtin_amdgcn_s_sleep(4); }
                __syncthreads();
                __builtin_amdgcn_fence(__ATOMIC_ACQUIRE, "agent");
                { v4u ldv[3][6]; prep_load(a, 2048 + it, ldv); prep_item(a, lds, 2048 + it, ldv, -1); }
            }
        } else {
            for (int u0 = bid; u0 < 32; u0 += G) {
                pg8::Gemm g{(const bf16*)(ws + WS_YIN), (const bf16*)(ws + WS_WIN) + (size_t)512 * 1024, MC, 1024, 1024}; pg8::StaticOrder S; S.init(MC, 1024, 32, u0);
                pg8::EpiBf16<0> E{(bf16*)(ws + WS_P) + P_SPLIT + (size_t)MX * 512, 512, nullptr, 512, P_SPLIT, 1.f};
                pg8::gemm_phase<pg8::EpiBf16<0>, pg8::StaticOrder, true, true>(lds, g, S, E);
            }
            xcd_barrier(bar);
            for (int it = bid; it < 2176; it += G) { v4u ldv[3][6]; prep_load(a, it, ldv); prep_item(a, lds, it, ldv, -1); }
        }
    }
    SEAM(3);
#ifndef SCAN_PROBE_MODE
#define SCAN_PROBE_MODE 0
#endif
    if (IN(4)) REP(4) { REPBAR();
        const int G = (int)gridDim.x, nscan = G >= 256 ? 128 : G;
        if ((int)blockIdx.x < nscan) { if (rep_ == 0) ph_scan<0>(a, lds, nscan); else ph_scan<SCAN_PROBE_MODE>(a, lds, nscan); }
        if (G < 256 || (int)blockIdx.x >= nscan) {
            const int ob = G >= 256 ? (int)blockIdx.x - nscan : (int)blockIdx.x, on = G >= 256 ? G - nscan : G;
            for (int it = ob; it < 2048; it += on) pool_item(a, lds, it);
            late_weights(a, lds, ob * 8 + (int)(threadIdx.x >> 6), on * 8);
        }
    }
    SEAM(4);
    if (IN(5)) REP(5) { REPBAR(); for (int it = blockIdx.x; it < 1024; it += gridDim.x) out_pair(a, lds, it); }
    SEAM(5);
    if (IN(6)) REP(6) {   REPBAR();
        pg8::Gemm g{(const bf16*)(ws + WS_YIN), (const bf16*)(ws + WS_WOUT), MX, 1024, 1024}; pg8::StaticOrder S; S.init(MX, 1024, (int)gridDim.x, (int)blockIdx.x);
        pg8::EpiBf16<0> E{(bf16*)(ws + WS_YX), 1024, nullptr, 0, 0, 1.f};
        pg8::gemm_phase<pg8::EpiBf16<0>, pg8::StaticOrder, true, true>(lds, g, S, E);
    }
    SEAM(6);
    if (IN(7)) REP(7) { REPBAR(); ph_mid(a); }
    SEAM(7);
    if (IN(8)) REP(8) {   REPBAR();
        pg8::Gemm g{(const bf16*)(ws + WS_XN), (const bf16*)(ws + WS_WUP), MX, DFF + 256, 1024}; pg8::StaticOrder S; S.init(MX, DFF + 256, (int)gridDim.x, (int)blockIdx.x);
        pg8::EpiBf16<0> E{(bf16*)(ws + WS_G), DFF, nullptr, DFF, (size_t)(WS_U - WS_G) / 2, 1.f};
        pg8::gemm_phase<pg8::EpiBf16<0>, pg8::StaticOrder, true, true>(lds, g, S, E);
    }
    SEAM(8);
    if (IN(9)) {
        ph_act<32>(a);
        pg8::Gemm g{(const bf16*)(ws + WS_XN), (const bf16*)(ws + WS_WUP) + (size_t)(DFF + 256) * 1024, MX, DFF - 256, 1024}; pg8::StaticOrder S; S.init(MX, DFF - 256, (int)gridDim.x, (int)blockIdx.x);
        pg8::EpiAct E{(const bf16*)(ws + WS_G) + 256, (bf16*)(ws + WS_U) + 256, DFF, a.in[19] + 256};
        pg8::gemm_phase<pg8::EpiAct, pg8::StaticOrder, true, true>(lds, g, S, E);
    }
    SEAM(9);
    if (IN(10)) REP(10) {  REPBAR();
        pg8::Gemm g{(const bf16*)(ws + WS_U), (const bf16*)(ws + WS_WDOWN), MX, 1024, DFF}; pg8::StaticOrder S; S.init(MX, 1024, (int)gridDim.x, (int)blockIdx.x);
        pg8::EpiBf16<0> E{(bf16*)(ws + WS_Y2), 1024, nullptr, 0, 0, 1.f};
        pg8::gemm_phase<pg8::EpiBf16<0>, pg8::StaticOrder, true, true>(lds, g, S, E);
    }
    SEAM(10);
    if (IN(11)) ph_final(a);
#undef IN
#undef SEAM
}

#ifndef MK_LAUNCHES
#define MK_LAUNCHES 1
#endif
extern "C" void kernel_launch(void* const* d_in, const int* in_sizes, int n_in, void* d_out, int out_size, void* d_ws, size_t ws_size, hipStream_t stream) {
    static int grid = 0;
    if (grid == 0) {
        int dev = 0, cus = 0, per_cu = 0;
        hipGetDevice(&dev);
        hipDeviceGetAttribute(&cus, hipDeviceAttributeMultiprocessorCount, dev);
        if (hipFuncSetAttribute((const void*)mega_fwd, hipFuncAttributeMaxDynamicSharedMemorySize, LDS_BYTES) != hipSuccess) { fprintf(stderr, "kernel_launch: hipFuncSetAttribute failed\n"); grid = -1; return; }
        if (hipOccupancyMaxActiveBlocksPerMultiprocessor(&per_cu, (const void*)mega_fwd, 512, LDS_BYTES) != hipSuccess || per_cu < 1) { fprintf(stderr, "kernel_launch: occupancy query failed (%d)\n", per_cu); per_cu = 1; }
        (void)hipGetLastError();
        grid = cus * 1;
        if (per_cu < 1 || cus < 1) grid = -1;
        if (ws_size < (size_t)512 * MiB) { fprintf(stderr, "kernel_launch: workspace too small: %zu\n", ws_size); grid = -1; }
    }
    if (grid < 0) return;
    if (hipMemsetAsync(d_ws, 0, 16384, stream) != hipSuccess) { fprintf(stderr, "kernel_launch: memset failed\n"); return; }
    Args a{};
    for (int i = 0; i < 21; ++i) a.in[i] = (const float*)d_in[i];
    a.out = (float*)d_out; a.ws = (unsigned char*)d_ws;
#if MK_LAUNCHES == 1
    a.ph_lo = 0; a.ph_hi = NPH;
    void* args[] = {&a};
    hipError_t e = hipLaunchCooperativeKernel((const void*)mega_fwd, dim3(grid), dim3(512), args, LDS_BYTES, stream);
    if (e != hipSuccess) fprintf(stderr, "cooperative launch failed: %s (grid %d)\n", hipGetErrorString(e), grid);
#else
    for (int p = 0; p < NPH; ++p) { a.ph_lo = p; a.ph_hi = p + 1; hipLaunchKernelGGL(mega_fwd, dim3(grid), dim3(512), LDS_BYTES, stream, a); }
#endif
}
```
